# Optimizing an MI355X kernel written in HIP

```python
import math
import jax, jax.numpy as jnp
from jax import lax
import numpy as np

D_MODEL = 2048
BATCH = 1
SEQ = 8192
DEPTH = 1

CHUNK = 64
MIX_WIDTH = D_MODEL
A_WIDTH = MIX_WIDTH // 2
A_HEADS = 8
A_HEAD_DIM = A_WIDTH // A_HEADS
GMLP_BLOCK = 128
B_WIDTH = MIX_WIDTH - A_WIDTH
S5_GROUP_CH = 16
S5_GROUPS = B_WIDTH // S5_GROUP_CH
S5_STATE = 64
IN_WIDTH = 2 * A_WIDTH + B_WIDTH
D_FF = int(math.ceil((8 * D_MODEL / 3) / 256) * 256)
EPS = 1e-6

kernel_name = "hybrid_gmlp_s5_parallel_block"


def rmsnorm(x, g):
    xf = x.astype(jnp.float32)
    y = xf * lax.rsqrt(jnp.mean(xf * xf, axis=-1, keepdims=True) + EPS)
    return (y * g.astype(jnp.float32)).astype(x.dtype)


def layernorm(x, g, b):
    xf = x.astype(jnp.float32)
    mu = jnp.mean(xf, axis=-1, keepdims=True)
    xc = xf - mu
    var = jnp.mean(xc * xc, axis=-1, keepdims=True)
    y = xc * lax.rsqrt(var + EPS) * g.astype(jnp.float32) + b.astype(jnp.float32)
    return y.astype(x.dtype)


def spatial_gating(z_u, z_v, ln_g, ln_b, w_s, b_s):
    bsz, seq, _ = z_u.shape
    nb = seq // GMLP_BLOCK
    v = layernorm(z_v, ln_g, ln_b).reshape(bsz, nb, GMLP_BLOCK, A_HEADS, A_HEAD_DIM)
    chunk_id = jnp.arange(GMLP_BLOCK) // CHUNK
    mask = chunk_id[:, None] >= chunk_id[None, :]
    w = jnp.where(mask[None], w_s, 0.0)
    v = jnp.einsum('hij,bnjhc->bnihc', w, v) + jnp.transpose(b_s)[None, None, :, :, None]
    return z_u * v.reshape(bsz, seq, A_WIDTH)


def _complex_linear_combine(e1, e2):
    a1r, a1i, b1r, b1i = e1
    a2r, a2i, b2r, b2i = e2
    return (a1r * a2r - a1i * a2i,
            a1r * a2i + a1i * a2r,
            a2r * b1r - a2i * b1i + b2r,
            a2r * b1i + a2i * b1r + b2i)


def s5_mixer(u, lam_re, lam_im, log_dt, b_re, b_im, c_re, c_im, d, w_glu):
    f32 = jnp.float32
    bsz, seq, _ = u.shape
    uf = u.astype(f32).reshape(bsz, seq, S5_GROUPS, S5_GROUP_CH)
    dt = jnp.exp(log_dt.astype(f32))[:, None]
    lr = lam_re.astype(f32)
    li = lam_im.astype(f32)
    mag = jnp.exp(lr * dt)
    ab_r = mag * jnp.cos(li * dt)
    ab_i = mag * jnp.sin(li * dt)
    den = lr * lr + li * li
    nr = ab_r - 1.0
    ni = ab_i
    co_r = (nr * lr + ni * li) / den
    co_i = (ni * lr - nr * li) / den
    br = b_re.astype(f32)
    bi = b_im.astype(f32)
    bb_r = co_r[..., None] * br - co_i[..., None] * bi
    bb_i = co_r[..., None] * bi + co_i[..., None] * br
    bu_r = jnp.einsum('blgh,gph->blgp', uf, bb_r)
    bu_i = jnp.einsum('blgh,gph->blgp', uf, bb_i)
    a_r = jnp.broadcast_to(ab_r, bu_r.shape)
    a_i = jnp.broadcast_to(ab_i, bu_i.shape)
    _, _, s_r, s_i = lax.associative_scan(_complex_linear_combine, (a_r, a_i, bu_r, bu_i), axis=1)
    y = (jnp.einsum('blgp,ghp->blgh', s_r, c_re.astype(f32))
         - jnp.einsum('blgp,ghp->blgh', s_i, c_im.astype(f32))
         + d.astype(f32).reshape(S5_GROUPS, S5_GROUP_CH) * uf)
    y = jax.nn.gelu(y, approximate=False)
    y = y * jax.nn.sigmoid(jnp.einsum('blgh,ghk->blgk', y, w_glu.astype(f32)))
    return y.reshape(bsz, seq, B_WIDTH).astype(u.dtype)


def setup_inputs(seed: int = 0) -> dict:
    key = jax.random.key(seed)
    ks = jax.random.split(key, 25)
    f32 = jnp.float32

    def nrm(k, shape, scale):
        return jax.random.normal(k, shape, f32) * scale

    L = DEPTH
    n = jnp.arange(S5_STATE, dtype=f32)
    return {
        "x": nrm(ks[0], (BATCH, SEQ, D_MODEL), 1.0),
        "norm_mix_g": 1.0 + nrm(ks[1], (L, D_MODEL), 0.02),
        "w_in": nrm(ks[2], (L, D_MODEL, IN_WIDTH), D_MODEL ** -0.5),
        "a_ln_g": 1.0 + nrm(ks[3], (L, A_WIDTH), 0.02),
        "a_ln_b": nrm(ks[4], (L, A_WIDTH), 0.02),
        "a_w_s": nrm(ks[5], (L, A_HEADS, GMLP_BLOCK, GMLP_BLOCK), GMLP_BLOCK ** -0.5),
        "a_b_s": 1.0 + nrm(ks[6], (L, A_HEADS, GMLP_BLOCK), 0.02),
        "s5_lambda_re": -0.5 + nrm(ks[7], (L, S5_GROUPS, S5_STATE), 0.01),
        "s5_lambda_im": jnp.pi * n + nrm(ks[8], (L, S5_GROUPS, S5_STATE), 0.01),
        "s5_log_dt": jax.random.uniform(ks[9], (L, S5_GROUPS), f32, math.log(1e-3), math.log(1e-1)),
        "s5_b_re": nrm(ks[10], (L, S5_GROUPS, S5_STATE, S5_GROUP_CH), (2 * S5_GROUP_CH) ** -0.5),
        "s5_b_im": nrm(ks[11], (L, S5_GROUPS, S5_STATE, S5_GROUP_CH), (2 * S5_GROUP_CH) ** -0.5),
        "s5_c_re": nrm(ks[12], (L, S5_GROUPS, S5_GROUP_CH, S5_STATE), S5_STATE ** -0.5),
        "s5_c_im": nrm(ks[13], (L, S5_GROUPS, S5_GROUP_CH, S5_STATE), S5_STATE ** -0.5),
        "s5_d": nrm(ks[14], (L, B_WIDTH), 1.0),
        "s5_w_glu": nrm(ks[15], (L, S5_GROUPS, S5_GROUP_CH, S5_GROUP_CH), S5_GROUP_CH ** -0.5),
        "out_norm_a_g": 1.0 + nrm(ks[16], (L, A_WIDTH), 0.02),
        "out_norm_b_g": 1.0 + nrm(ks[17], (L, B_WIDTH), 0.02),
        "w_out": nrm(ks[18], (L, MIX_WIDTH, D_MODEL), MIX_WIDTH ** -0.5),
        "norm_ffn_g": 1.0 + nrm(ks[19], (L, D_MODEL), 0.02),
        "w_gate": nrm(ks[20], (L, D_MODEL, D_FF), D_MODEL ** -0.5),
        "w_up": nrm(ks[21], (L, D_MODEL, D_FF), D_MODEL ** -0.5),
        "w_down": nrm(ks[22], (L, D_FF, D_MODEL), D_FF ** -0.5),
        "final_norm_g": 1.0 + nrm(ks[23], (D_MODEL,), 0.02),
    }


def reference(x, norm_mix_g, w_in, a_ln_g, a_ln_b, a_w_s, a_b_s, s5_lambda_re, s5_lambda_im,
              s5_log_dt, s5_b_re, s5_b_im, s5_c_re, s5_c_im, s5_d, s5_w_glu, out_norm_a_g,
              out_norm_b_g, w_out, norm_ffn_g, w_gate, w_up, w_down, final_norm_g):
    for l in range(DEPTH):
        h = jnp.einsum('bsd,de->bse', rmsnorm(x, norm_mix_g[l]), w_in[l])
        z = jax.nn.gelu(h[..., :2 * A_WIDTH], approximate=False)
        y_a = spatial_gating(z[..., :A_WIDTH], z[..., A_WIDTH:], a_ln_g[l], a_ln_b[l],
                             a_w_s[l], a_b_s[l])
        y_b = s5_mixer(h[..., 2 * A_WIDTH:], s5_lambda_re[l], s5_lambda_im[l], s5_log_dt[l],
                       s5_b_re[l], s5_b_im[l], s5_c_re[l], s5_c_im[l], s5_d[l],
                       s5_w_glu[l])
        mix = jnp.concatenate([rmsnorm(y_a, out_norm_a_g[l]),
                               rmsnorm(y_b, out_norm_b_g[l])], axis=-1)
        x = x + jnp.einsum('bse,ed->bsd', mix, w_out[l])
        hn = rmsnorm(x, norm_ffn_g[l])
        g = jnp.einsum('bsd,df->bsf', hn, w_gate[l])
        up = jnp.einsum('bsd,df->bsf', hn, w_up[l])
        x = x + jnp.einsum('bsf,fd->bsd', jax.nn.silu(g) * up, w_down[l])
    return rmsnorm(x, final_norm_g)
```

```cpp
#include <hip/hip_runtime.h>
#include <cstdio>
#include <cstdint>
#include <cmath>
namespace pg8 {
#define PG8_LAS __attribute__((address_space(3)))
typedef unsigned short bf16_t;
typedef short bf16x8 __attribute__((ext_vector_type(8)));
typedef float f32x4 __attribute__((ext_vector_type(4)));
typedef unsigned u32x4 __attribute__((ext_vector_type(4)));
constexpr int BM = 256, BK = 64, HALF = 128, HTB = HALF * BK * 2  , STAGE_BYTES = 8 * HTB, NXCD = 8, WGM = 8;

__host__ __device__ __forceinline__ int lds_byte(int r, int c) { const int st = (r >> 4) * 2 + (c >> 5), rr = r & 15, cc = c & 31, ob = rr * 64 + cc * 2; return st * 1024 + (ob ^ (((ob >> 9) & 1) << 5)); }
__host__ __device__ __forceinline__ void stage_rc(int b, int& R, int& C) { const int st = b / 1024, sb = b % 1024, swz = sb ^ (((sb >> 9) & 1) << 5); R = (st >> 1) * 16 + swz / 64; C = (st & 1) * 32 + (swz % 64) / 2; }
__host__ __device__ __forceinline__ int perm32(int rho) { const int n = rho >> 4, i = rho & 15; return 8 * (i >> 2) + 4 * n + (i & 3); }

struct Unit { int pm, pn; };
struct Gemm { const bf16_t* A; const bf16_t* Bt; int M, N, K; };

struct StaticOrder {
    int nM, nN, nwg, G, c;
    __host__ __device__ void init(int M, int N, int G_, int c_) { nM = M / BM; nN = N / BM; nwg = nM * nN; G = G_; c = c_; }
    __host__ __device__ bool next(int i, Unit& u) const {
        const long L = (long)i * G + c; if (L >= nwg) return false;
        int wgid = (int)L; { const int q = nwg / NXCD, r = nwg % NXCD, xcd = wgid % NXCD, off = wgid / NXCD; wgid = (xcd < r ? xcd * (q + 1) : r * (q + 1) + (xcd - r) * q) + off; }
        const int nig = WGM * nN, gid = wgid / nig, fm = gid * WGM, gsz = (nM - fm) < WGM ? (nM - fm) : WGM;
        u.pm = fm + ((wgid % nig) % gsz); u.pn = (wgid % nig) / gsz; return true;
    }
    __device__ __forceinline__ void a_ready(const Unit&) const {}
    __device__ __forceinline__ void done(const Unit&) const {}
};

__device__ __forceinline__ unsigned cvt_pk_bf16(float lo, float hi) { unsigned r; asm volatile("v_cvt_pk_bf16_f32 %0, %1, %2" : "=v"(r) : "v"(lo), "v"(hi)); return r; }
typedef float f32x2 __attribute__((ext_vector_type(2)));
__device__ __forceinline__ f32x2 gelu_pk(f32x2 v) {
    const f32x2 av = __builtin_elementwise_abs(v), d = av * 0.2316418882f + 1.0f;
    f32x2 t; t.x = __builtin_amdgcn_rcpf(d.x); t.y = __builtin_amdgcn_rcpf(d.y);
    f32x2 q = t * 0.5307027145f + (-0.7265760135f); q = q * t + 0.7107068705f; q = q * t + (-0.142248368f); q = q * t + 0.127414796f; q = q * t;
    const f32x2 s = (v * v) * (-0.72134752044f);
    f32x2 e; e.x = __builtin_amdgcn_exp2f(s.x); e.y = __builtin_amdgcn_exp2f(s.y);
    const f32x2 m = v * (q * e), r = v - m;
    f32x2 o; o.x = v.x < 0.f ? m.x : r.x; o.y = v.y < 0.f ? m.y : r.y; return o;
}


typedef unsigned u32x2 __attribute__((ext_vector_type(2)));
typedef __bf16 bf16x2_t __attribute__((ext_vector_type(2)));
__device__ __forceinline__ unsigned cvtpk_s(float lo, float hi) { f32x2 v = {lo, hi}; bf16x2_t b = __builtin_convertvector(v, bf16x2_t); return __builtin_bit_cast(unsigned, b); }
constexpr int XT_OFF = 131072;
constexpr int XT_RHO = XT_OFF, XT_RB = XT_OFF + 1024;
constexpr int P_SEQ = 8192, P_DM = 2048, P_AW = 1024, P_DFF = 5632, P_NCHUNK = 512, P_ASK = 384;
constexpr float P_EPS = 1e-6f;

struct EpiIn {
    static constexpr bool PERM = true, AFTER_DRAIN = false, MIDK = false;
    bf16_t* U; bf16_t* V; bf16_t* AS; float* LNST;
    __device__ __forceinline__ void operator()(const f32x4 (&acc)[2][2][4][2], const Unit& u, int wr, int wc, int fr, int fq) const {
        const int kind = u.pn >> 2;
        const int row0 = u.pm * BM + wr * 64 + fr;
        const int colt = (u.pn & 3) * BM + wc * 32 + 8 * fq;
        if (kind == 2) {
#pragma unroll
            for (int ai = 0; ai < 2; ++ai)
#pragma unroll
                for (int m = 0; m < 4; ++m) { const int row = row0 + ai * HALF + m * 16; const int chunk = row >> 4, t = row & 15;
#pragma unroll
                    for (int bj = 0; bj < 2; ++bj) { const int cs = colt + bj * HALF; const int g = cs >> 4, c8 = cs & 15;
                        const f32x4 v0 = acc[ai][bj][m][0], v1 = acc[ai][bj][m][1];
                        u32x4 w; w.x = cvt_pk_bf16(v0[0], v0[1]); w.y = cvt_pk_bf16(v0[2], v0[3]); w.z = cvt_pk_bf16(v1[0], v1[1]); w.w = cvt_pk_bf16(v1[2], v1[3]);
                        *(u32x4*)(AS + ((size_t)(g * P_NCHUNK + chunk) * P_ASK + t * 16 + c8)) = w; } }
        } else {
            bf16_t* base = (kind == 0) ? U : V;
#pragma unroll
            for (int ai = 0; ai < 2; ++ai)
#pragma unroll
                for (int m = 0; m < 4; ++m) { const int row = row0 + ai * HALF + m * 16; float s = 0.f, ss = 0.f;
#pragma unroll
                    for (int bj = 0; bj < 2; ++bj) { f32x4 v0 = acc[ai][bj][m][0], v1 = acc[ai][bj][m][1];
                        const f32x2 a = gelu_pk((f32x2){v0[0], v0[1]}), b = gelu_pk((f32x2){v0[2], v0[3]}), c = gelu_pk((f32x2){v1[0], v1[1]}), d = gelu_pk((f32x2){v1[2], v1[3]});
                        s += ((a.x + a.y) + (b.x + b.y)) + ((c.x + c.y) + (d.x + d.y));
                        ss += ((a.x * a.x + a.y * a.y) + (b.x * b.x + b.y * b.y)) + ((c.x * c.x + c.y * c.y) + (d.x * d.x + d.y * d.y));
                        u32x4 w; w.x = cvt_pk_bf16(a.x, a.y); w.y = cvt_pk_bf16(b.x, b.y); w.z = cvt_pk_bf16(c.x, c.y); w.w = cvt_pk_bf16(d.x, d.y);
                        *(u32x4*)(base + (size_t)row * P_AW + colt + bj * HALF) = w; }
                    if (kind == 1) { s += __shfl_xor(s, 16); s += __shfl_xor(s, 32); ss += __shfl_xor(ss, 16); ss += __shfl_xor(ss, 32);
                        if (fq == 0) *(f32x2*)(LNST + ((size_t)row * 16 + (u.pn & 3) * 4 + wc) * 2) = (f32x2){s, ss}; } }
        }
    }
};

struct EpiOut {
    static constexpr bool PERM = false, AFTER_DRAIN = true, MIDK = true;
    const float* x; float* out; bf16_t* X1B; float* X1ST;
    __device__ __forceinline__ void midk(f32x4 (&acc)[2][2][4][2], int wr, int fr, PG8_LAS unsigned char* lds) const {
        const PG8_LAS float* RHO = (const PG8_LAS float*)(lds + XT_RHO);
#pragma unroll
        for (int ai = 0; ai < 2; ++ai)
#pragma unroll
            for (int m = 0; m < 4; ++m) { const float r = RHO[ai * HALF + wr * 64 + m * 16 + fr];
#pragma unroll
                for (int bj = 0; bj < 2; ++bj)
#pragma unroll
                    for (int n = 0; n < 2; ++n) acc[ai][bj][m][n] = acc[ai][bj][m][n] * r; }
    }
    __device__ __forceinline__ void fused(f32x4 (&acc)[2][2][4][2], const Unit& u, int wr, int wc, int fr, int fq, PG8_LAS unsigned char* lds, int wid, int lane) const {
        const PG8_LAS float* RB = (const PG8_LAS float*)(lds + XT_RB);
        PG8_LAS float* P = (PG8_LAS float*)lds;
        const int col0 = u.pn * BM + wc * 32 + 4 * fq;
#pragma unroll
        for (int ai = 0; ai < 2; ++ai)
#pragma unroll
            for (int m = 0; m < 4; ++m) { const int r = ai * HALF + wr * 64 + m * 16 + fr; const float rb = RB[r]; const size_t off = (size_t)(u.pm * BM + r) * P_DM + col0; float q = 0.f;
#pragma unroll
                for (int bj = 0; bj < 2; ++bj)
#pragma unroll
                    for (int n = 0; n < 2; ++n) { const f32x4 xv = *(const f32x4*)(x + off + bj * HALF + n * 16); const f32x4 o = xv + acc[ai][bj][m][n] * rb;
                        *(f32x4*)(out + off + bj * HALF + n * 16) = o;
                        u32x2 w; w.x = cvt_pk_bf16(o[0], o[1]); w.y = cvt_pk_bf16(o[2], o[3]); *(u32x2*)(X1B + off + bj * HALF + n * 16) = w;
                        q += (o[0] * o[0] + o[1] * o[1]) + (o[2] * o[2] + o[3] * o[3]); }
                q += __shfl_xor(q, 16); q += __shfl_xor(q, 32);
                if (fq == 0) P[r * 4 + wc] = q;
                if (m & 1) asm volatile("" ::: "memory"); }
        asm volatile("s_waitcnt lgkmcnt(0)" ::: "memory"); __builtin_amdgcn_s_barrier(); asm volatile("" ::: "memory");
        const int t = wid * 64 + lane;
        if (t < 256) X1ST[(size_t)(u.pm * BM + t) * 8 + u.pn] = (P[t * 4 + 0] + P[t * 4 + 1]) + (P[t * 4 + 2] + P[t * 4 + 3]);
    }
};

struct EpiGU {
    static constexpr bool PERM = true, AFTER_DRAIN = false, MIDK = false;
    bf16_t* H; const float* X1ST;
    __device__ __forceinline__ void operator()(const f32x4 (&acc)[2][2][4][2], const Unit& u, int wr, int wc, int fr, int fq) const {
        const int row0 = u.pm * BM + wr * 64 + fr; const int col0 = u.pn * HALF + wc * 32 + 8 * fq;
#pragma unroll
        for (int ai = 0; ai < 2; ++ai)
#pragma unroll
            for (int m = 0; m < 4; ++m) { const int row = row0 + ai * HALF + m * 16;
                const f32x4 s0 = *(const f32x4*)(X1ST + (size_t)row * 8), s1 = *(const f32x4*)(X1ST + (size_t)row * 8 + 4);
                const float r = __builtin_amdgcn_rsqf((((s0[0] + s0[1]) + (s0[2] + s0[3])) + ((s1[0] + s1[1]) + (s1[2] + s1[3]))) * (1.0f / P_DM) + P_EPS);
                float hv[8];
#pragma unroll
                for (int n = 0; n < 2; ++n)
#pragma unroll
                    for (int j = 0; j < 4; ++j) { const float g = acc[ai][0][m][n][j] * r, up = acc[ai][1][m][n][j] * r;
                        const float e = __builtin_amdgcn_exp2f(g * (-1.4426950408889634f)); hv[n * 4 + j] = g * __builtin_amdgcn_rcpf(1.0f + e) * up; }
                u32x4 w; w.x = cvt_pk_bf16(hv[0], hv[1]); w.y = cvt_pk_bf16(hv[2], hv[3]); w.z = cvt_pk_bf16(hv[4], hv[5]); w.w = cvt_pk_bf16(hv[6], hv[7]);
                *(u32x4*)(H + (size_t)row * P_DFF + col0) = w; }
    }
};

struct EpiDown {
    static constexpr bool PERM = false, AFTER_DRAIN = true, MIDK = false;
    float* out; float* X2ST;
    __device__ __forceinline__ void fused(f32x4 (&acc)[2][2][4][2], const Unit& u, int wr, int wc, int fr, int fq, PG8_LAS unsigned char* lds, int wid, int lane) const {
        PG8_LAS float* P = (PG8_LAS float*)lds;
        const int col0 = u.pn * BM + wc * 32 + 4 * fq;
#pragma unroll
        for (int ai = 0; ai < 2; ++ai)
#pragma unroll
            for (int m = 0; m < 4; ++m) { const int r = ai * HALF + wr * 64 + m * 16 + fr; const size_t off = (size_t)(u.pm * BM + r) * P_DM + col0; float q = 0.f;
#pragma unroll
                for (int bj = 0; bj < 2; ++bj)
#pragma unroll
                    for (int n = 0; n < 2; ++n) { const f32x4 xv = *(const f32x4*)(out + off + bj * HALF + n * 16); const f32x4 o = xv + acc[ai][bj][m][n];
                        *(f32x4*)(out + off + bj * HALF + n * 16) = o; q += (o[0] * o[0] + o[1] * o[1]) + (o[2] * o[2] + o[3] * o[3]); }
                q += __shfl_xor(q, 16); q += __shfl_xor(q, 32);
                if (fq == 0) P[r * 4 + wc] = q;
                if (m & 1) asm volatile("" ::: "memory"); }
        asm volatile("s_waitcnt lgkmcnt(0)" ::: "memory"); __builtin_amdgcn_s_barrier(); asm volatile("" ::: "memory");
        const int t = wid * 64 + lane;
        if (t < 256) X2ST[(size_t)(u.pm * BM + t) * 8 + u.pn] = (P[t * 4 + 0] + P[t * 4 + 1]) + (P[t * 4 + 2] + P[t * 4 + 3]);
    }
};

struct S5Order {
    int G, c;
    __device__ bool next(int i, Unit& u) const { const int L = i * G + c; if (L >= 128) return false; u.pm = L; u.pn = L >> 1; return true; }
    __device__ __forceinline__ void a_ready(const Unit&) const {}
    __device__ __forceinline__ void done(const Unit&) const {}
};
typedef short bf16x4 __attribute__((ext_vector_type(4)));
struct EpiS5 {
    static constexpr bool PERM = false, AFTER_DRAIN = true, MIDK = false;
    const bf16_t* AS; const float* dvec; const float* wglu; bf16_t* MIX; float* YBST;
    __device__ __forceinline__ void fused(f32x4 (&acc)[2][2][4][2], const Unit& u, int wr, int wc, int fr, int fq, PG8_LAS unsigned char* lds, int wid, int lane) const {
        const int g = u.pn; const int chunk0 = (u.pm & 1) * 256 + wr * 64 + fr;
        bf16x4 wf; { const float* wp = wglu + (size_t)(g * 16 + 4 * fq) * 16 + fr;
            const unsigned a = cvtpk_s(wp[0], wp[16]), b = cvtpk_s(wp[32], wp[48]); wf = __builtin_bit_cast(bf16x4, (u32x2){a, b}); }
        const f32x4 dv = *(const f32x4*)(dvec + g * 16 + 4 * fq);
#pragma unroll
        for (int ai = 0; ai < 2; ++ai)
#pragma unroll
            for (int m = 0; m < 4; ++m) { const int chunk = chunk0 + ai * HALF + m * 16; const bf16_t* arow = AS + (size_t)(g * P_NCHUNK + chunk) * P_ASK + 4 * fq;
#pragma unroll
                for (int bj = 0; bj < 2; ++bj)
#pragma unroll
                    for (int n = 0; n < 2; ++n) { const int t = 8 * bj + 2 * wc + n; const int pos = chunk * 16 + t;
                        const u32x2 uw = *(const u32x2*)(arow + t * 16);
                        f32x4 y = acc[ai][bj][m][n];
                        y[0] += dv[0] * __builtin_bit_cast(float, uw.x << 16); y[1] += dv[1] * __builtin_bit_cast(float, uw.x & 0xffff0000u);
                        y[2] += dv[2] * __builtin_bit_cast(float, uw.y << 16); y[3] += dv[3] * __builtin_bit_cast(float, uw.y & 0xffff0000u);
                        const f32x2 ya = gelu_pk((f32x2){y[0], y[1]}), yb = gelu_pk((f32x2){y[2], y[3]});
                        const bf16x4 yf = __builtin_bit_cast(bf16x4, (u32x2){cvtpk_s(ya.x, ya.y), cvtpk_s(yb.x, yb.y)});
                        const f32x4 z = __builtin_amdgcn_mfma_f32_16x16x16bf16_1k(wf, yf, (f32x4){0.f, 0.f, 0.f, 0.f}, 0, 0, 0);
                        f32x4 o;
                        o[0] = ya.x * __builtin_amdgcn_rcpf(1.0f + __builtin_amdgcn_exp2f(z[0] * (-1.4426950408889634f)));
                        o[1] = ya.y * __builtin_amdgcn_rcpf(1.0f + __builtin_amdgcn_exp2f(z[1] * (-1.4426950408889634f)));
                        o[2] = yb.x * __builtin_amdgcn_rcpf(1.0f + __builtin_amdgcn_exp2f(z[2] * (-1.4426950408889634f)));
                        o[3] = yb.y * __builtin_amdgcn_rcpf(1.0f + __builtin_amdgcn_exp2f(z[3] * (-1.4426950408889634f)));
                        u32x2 w; w.x = cvt_pk_bf16(o[0], o[1]); w.y = cvt_pk_bf16(o[2], o[3]);
                        *(u32x2*)(MIX + (size_t)pos * P_DM + P_AW + g * 16 + 4 * fq) = w;
                        float q = (o[0] * o[0] + o[1] * o[1]) + (o[2] * o[2] + o[3] * o[3]);
                        q += __shfl_xor(q, 16); q += __shfl_xor(q, 32);
                        if (fq == 0) YBST[(size_t)pos * 64 + g] = q; }
                asm volatile("" ::: "memory"); }
    }
};
template <class Epi, class Sched, bool ALIGN_EPI = false, bool SP2 = false>
__device__ __forceinline__ void gemm_phase(PG8_LAS unsigned char* lds, const Gemm g, const Sched& S, const Epi& E) {
    const int tid = threadIdx.x, wid = __builtin_amdgcn_readfirstlane(tid >> 6), lane = tid & 63, wr = wid >> 2, wc = wid & 3, fr = lane & 15, fq = lane >> 4;
    const int K = g.K, nt = K / BK;
    unsigned voffA[2], voffB[2];
#pragma unroll
    for (int i = 0; i < 2; ++i) { int R, C; stage_rc(tid * 16 + i * 8192, R, C); const int Rb = Epi::PERM ? ((R & ~31) + perm32(R & 31)) : R;
        voffA[i] = (unsigned)(R * K + C) * 2u; voffB[i] = (unsigned)(Rb * K + C) * 2u; }
    const size_t kstep = (size_t)(BK * 2);
    const size_t hstep = (size_t)HALF * K * 2;
    const size_t tstep = 2 * hstep;
    const unsigned ldsw = (unsigned)wid * 1024u;
    const int aoff = lds_byte(wr * 64 + fr, fq * 8), boff = lds_byte(wc * 32 + fr, fq * 8);
#define PG8_SA(b, h) (((b) * 2 + (h)) * HTB)
#define PG8_SB(b, h) ((4 + (b) * 2 + (h)) * HTB)
#define PG8_STAGE(bufoff, gbase, voff) do { _Pragma("unroll") for (int _i = 0; _i < 2; ++_i) \
        __builtin_amdgcn_global_load_lds((const unsigned*)((const char*)(gbase) + (voff)[_i]), (PG8_LAS unsigned*)(lds + (bufoff) + ldsw + _i * 8192), 16, 0, 0); } while (0)
#define PG8_LDA(dst, b, h) do { _Pragma("unroll") for (int m = 0; m < 4; ++m) _Pragma("unroll") for (int k = 0; k < 2; ++k) dst[m][k] = *(const PG8_LAS bf16x8*)(lds + PG8_SA(b, h) + aoff + m * 2048 + k * 1024); } while (0)
#define PG8_LDB(dst, b, h) do { _Pragma("unroll") for (int n = 0; n < 2; ++n) _Pragma("unroll") for (int k = 0; k < 2; ++k) dst[n][k] = *(const PG8_LAS bf16x8*)(lds + PG8_SB(b, h) + boff + n * 2048 + k * 1024); } while (0)
#define PG8_MMA(ai, bj, At, Bt) do { __builtin_amdgcn_s_setprio(1); _Pragma("unroll") for (int m = 0; m < 4; ++m) _Pragma("unroll") for (int n = 0; n < 2; ++n) _Pragma("unroll") for (int k = 0; k < 2; ++k) \
        acc[ai][bj][m][n] = __builtin_amdgcn_mfma_f32_16x16x32_bf16(Bt[n][k], At[m][k], acc[ai][bj][m][n], 0, 0, 0); __builtin_amdgcn_s_setprio(0); } while (0)
#define PG8_WAIT_V(n) asm volatile("s_waitcnt vmcnt(" #n ")" ::: "memory")
#define PG8_WAIT_L(n) asm volatile("s_waitcnt lgkmcnt(" #n ")" ::: "memory")
#define PG8_BAR __builtin_amdgcn_s_barrier()
#define PG8_SCHED __builtin_amdgcn_sched_barrier(0)
    Unit cur, nxt; int ui = 0;
    if (!S.next(0, cur)) return;
    f32x4 acc[2][2][4][2];
#pragma unroll
    for (int a = 0; a < 2; ++a)
#pragma unroll
        for (int b = 0; b < 2; ++b)
#pragma unroll
            for (int m = 0; m < 4; ++m)
#pragma unroll
                for (int n = 0; n < 2; ++n) acc[a][b][m][n] = (f32x4){0.f, 0.f, 0.f, 0.f};
    bf16x8 At[4][2], B0[2][2], B1[2][2];
    const char* cA = (const char*)g.A + (size_t)cur.pm * tstep; const char* cB = (const char*)g.Bt + (size_t)cur.pn * tstep;
    S.a_ready(cur);
    if constexpr (SP2) {
        PG8_STAGE(PG8_SB(0, 0), cB, voffB); PG8_STAGE(PG8_SB(0, 1), cB + hstep, voffB); PG8_STAGE(PG8_SA(0, 0), cA, voffA); PG8_STAGE(PG8_SA(0, 1), cA + hstep, voffA);
        if (wr == 1) PG8_BAR;
        PG8_WAIT_V(2); PG8_BAR;
        PG8_STAGE(PG8_SB(1, 0), cB + kstep, voffB); PG8_STAGE(PG8_SA(1, 0), cA + kstep, voffA); PG8_STAGE(PG8_SB(1, 1), cB + hstep + kstep, voffB);
        PG8_WAIT_V(6); PG8_BAR;
    } else {
        PG8_STAGE(PG8_SB(0, 0), cB, voffB); PG8_STAGE(PG8_SA(0, 0), cA, voffA); PG8_STAGE(PG8_SB(0, 1), cB + hstep, voffB); PG8_STAGE(PG8_SA(0, 1), cA + hstep, voffA);
        if (wr == 1) PG8_BAR;
        PG8_WAIT_V(4); PG8_BAR;
        PG8_STAGE(PG8_SB(1, 0), cB + kstep, voffB); PG8_STAGE(PG8_SA(1, 0), cA + kstep, voffA); PG8_STAGE(PG8_SB(1, 1), cB + hstep + kstep, voffB);
        PG8_WAIT_V(6); PG8_BAR;
    }
    for (;;) {
        const bool has_next = S.next(ui + 1, nxt);
        const char* nA = has_next ? (const char*)g.A + (size_t)nxt.pm * tstep : cA; const char* nB = has_next ? (const char*)g.Bt + (size_t)nxt.pn * tstep : cB;
        for (int t = 0; t < nt; t += 2) {
            const bool last = (t == nt - 2);
            if constexpr (Epi::MIDK) { if (t == (nt >> 1)) E.midk(acc, wr, fr, lds); }
            const char* a1 = cA + (size_t)(t + 1) * kstep;
            const char* a2 = last ? nA : cA + (size_t)(t + 2) * kstep; const char* b2 = last ? nB : cB + (size_t)(t + 2) * kstep;
            const char* a3 = a2 + kstep; const char* b3 = b2 + kstep;
            if (last && has_next) S.a_ready(nxt);
            if constexpr (SP2) {
            PG8_LDB(B0, 0, 0); PG8_LDB(B1, 0, 1); PG8_SCHED; PG8_LDA(At, 0, 0); PG8_STAGE(PG8_SA(1, 1), a1 + hstep, voffA);
            PG8_WAIT_V(8); PG8_WAIT_L(0); PG8_BAR; PG8_MMA(0, 0, At, B0); PG8_MMA(0, 1, At, B1); PG8_BAR; PG8_SCHED;
            PG8_LDA(At, 0, 1); PG8_STAGE(PG8_SB(0, 0), b2, voffB); PG8_STAGE(PG8_SB(0, 1), b2 + hstep, voffB); PG8_STAGE(PG8_SA(0, 0), a2, voffA);
            PG8_WAIT_V(8); PG8_WAIT_L(0); PG8_BAR; PG8_MMA(1, 0, At, B0); PG8_MMA(1, 1, At, B1); PG8_BAR; PG8_SCHED;
            PG8_LDB(B0, 1, 0); PG8_LDB(B1, 1, 1); PG8_SCHED; PG8_LDA(At, 1, 0); PG8_STAGE(PG8_SA(0, 1), a2 + hstep, voffA);
            PG8_WAIT_V(8); PG8_WAIT_L(0); PG8_BAR; PG8_MMA(0, 0, At, B0); PG8_MMA(0, 1, At, B1); PG8_BAR; PG8_SCHED;
            PG8_LDA(At, 1, 1); PG8_STAGE(PG8_SB(1, 0), b3, voffB); PG8_STAGE(PG8_SB(1, 1), b3 + hstep, voffB); PG8_STAGE(PG8_SA(1, 0), a3, voffA);
            PG8_WAIT_V(8); PG8_WAIT_L(0); PG8_BAR; PG8_MMA(1, 0, At, B0); PG8_MMA(1, 1, At, B1); PG8_BAR; PG8_SCHED;
            } else {
            PG8_LDB(B0, 0, 0); PG8_SCHED; PG8_LDA(At, 0, 0); PG8_STAGE(PG8_SA(1, 1), a1 + hstep, voffA);
            PG8_WAIT_L(8); PG8_BAR; PG8_WAIT_L(0); PG8_MMA(0, 0, At, B0); PG8_BAR; PG8_SCHED;
            PG8_LDB(B1, 0, 1); PG8_STAGE(PG8_SB(0, 0), b2, voffB);
            PG8_BAR; PG8_WAIT_L(0); PG8_MMA(0, 1, At, B1); PG8_BAR;
            PG8_LDA(At, 0, 1); PG8_STAGE(PG8_SA(0, 0), a2, voffA);
            PG8_BAR; PG8_WAIT_L(0); PG8_MMA(1, 0, At, B0); PG8_BAR; PG8_SCHED;
            PG8_STAGE(PG8_SB(0, 1), b2 + hstep, voffB);
            PG8_WAIT_V(6); PG8_BAR; PG8_MMA(1, 1, At, B1); PG8_BAR;
            PG8_LDB(B0, 1, 0); PG8_SCHED; PG8_LDA(At, 1, 0); PG8_STAGE(PG8_SA(0, 1), a2 + hstep, voffA);
            PG8_WAIT_L(8); PG8_BAR; PG8_WAIT_L(0); PG8_MMA(0, 0, At, B0); PG8_BAR; PG8_SCHED;
            PG8_LDB(B1, 1, 1); PG8_STAGE(PG8_SB(1, 0), b3, voffB);
            PG8_BAR; PG8_WAIT_L(0); PG8_MMA(0, 1, At, B1); PG8_BAR;
            PG8_LDA(At, 1, 1); PG8_STAGE(PG8_SA(1, 0), a3, voffA);
            PG8_BAR; PG8_WAIT_L(0); PG8_MMA(1, 0, At, B0); PG8_BAR; PG8_SCHED;
            PG8_STAGE(PG8_SB(1, 1), b3 + hstep, voffB);
            PG8_WAIT_V(6); PG8_BAR; PG8_MMA(1, 1, At, B1); PG8_BAR;
            }
        }
        if constexpr (ALIGN_EPI) { if (wr == 0) PG8_BAR; }
        if constexpr (!Epi::AFTER_DRAIN) { E(acc, cur, wr, wc, fr, fq); S.done(cur); }
        if (!has_next) break;
#pragma unroll
        for (int a = 0; a < 2; ++a)
#pragma unroll
            for (int b = 0; b < 2; ++b)
#pragma unroll
                for (int m = 0; m < 4; ++m)
#pragma unroll
                    for (int n = 0; n < 2; ++n) acc[a][b][m][n] = (f32x4){0.f, 0.f, 0.f, 0.f};
        cur = nxt; cA = nA; cB = nB; ++ui;
        if constexpr (ALIGN_EPI) { if (wr == 1) PG8_BAR; }
    }
    PG8_WAIT_V(0);
    if constexpr (!ALIGN_EPI) { if (wr == 0) PG8_BAR; }
    PG8_BAR;
    if constexpr (Epi::AFTER_DRAIN) { E.fused(acc, cur, wr, wc, fr, fq, lds, wid, lane); S.done(cur); }
#undef PG8_SA
#undef PG8_SB
#undef PG8_STAGE
#undef PG8_LDA
#undef PG8_LDB
#undef PG8_MMA
#undef PG8_WAIT_V
#undef PG8_WAIT_L
#undef PG8_BAR
#undef PG8_SCHED
}
}


using pg8::bf16_t; using pg8::f32x4; using pg8::u32x4; using pg8::u32x2; using pg8::f32x2;
constexpr int NWAVES = 8;
constexpr int SEQ = 8192, DM = 2048, AW = 1024, BW = 1024, INW = 3072, DFF = 5632, NG = 64, NCHUNK = 512, ASK = 384;
constexpr float EPS = 1e-6f;
constexpr size_t MiB = 1u << 20;
constexpr size_t WS_CTL = 0, CTL_ZERO_BYTES = 1 * MiB;
constexpr size_t WS_LNST = 1 * MiB;
constexpr size_t WS_X1ST = 2 * MiB;
constexpr size_t WS_X2ST = 2 * MiB + 256 * 1024;
constexpr size_t WS_YAST = 2 * MiB + 512 * 1024;
constexpr size_t WS_A16 = 2 * MiB + 768 * 1024;
constexpr size_t WS_WM = 3 * MiB;
constexpr size_t WS_WIN = 4 * MiB, WS_WOUT = 16 * MiB, WS_WGU = 24 * MiB, WS_WD = 68 * MiB;
constexpr size_t WS_MQ = 90 * MiB, WS_PT = 102 * MiB, WS_SPREV = 106 * MiB;
constexpr size_t WS_XN = 114 * MiB;
constexpr size_t WS_U = 146 * MiB, WS_V = 162 * MiB, WS_AS = 178 * MiB;
constexpr size_t WS_MIX = 202 * MiB;
constexpr size_t WS_H = 146 * MiB;
constexpr size_t WS_E = 234 * MiB;
constexpr size_t WS_YBST = 250 * MiB;
constexpr size_t WS_END = 252 * MiB;
static_assert(WS_H + (size_t)SEQ * DFF * 2 <= WS_END && WS_MIX + (size_t)SEQ * DM * 2 <= WS_END && WS_END <= 256 * MiB, "d_ws map");

constexpr int LDS_BYTES = 147456;
constexpr int MISC_OFF = 131072 + 4096;

#define GAS __attribute__((address_space(1)))
#define LAS __attribute__((address_space(3)))
#define LDS_WAIT() asm volatile("s_waitcnt lgkmcnt(0)" ::: "memory")
__device__ __forceinline__ unsigned f2bf(float f) { unsigned u = __builtin_bit_cast(unsigned, f); return (u + 0x7fffu + ((u >> 16) & 1u)) >> 16; }
__device__ __forceinline__ unsigned pk2(float lo, float hi) { return f2bf(lo) | (f2bf(hi) << 16); }
__device__ __forceinline__ float bf2f(bf16_t b) { return __builtin_bit_cast(float, (unsigned)b << 16); }
__device__ __forceinline__ float wave_sum(float v) {
#pragma unroll
    for (int o = 1; o < 64; o <<= 1) v += __shfl_xor(v, o);
    return v;
}

#define XB_TMO      128
#define XB_XCNT(j)  (256  + 64 * (j))
#define XB_XSUB(j)  (1280 + 64 * (j))
#define XB_XGEN(j)  (2304 + 64 * (j))
#define XB_TOP      3328
#define XB_TOPGEN   3392
#define XCD_BAR_WORDS 3456
#define XB_SPIN_CAP (1u << 18)

__device__ __forceinline__ unsigned xb_ld(unsigned* p)              { return __hip_atomic_load(p, __ATOMIC_RELAXED, __HIP_MEMORY_SCOPE_AGENT); }
__device__ __forceinline__ unsigned xb_add(unsigned* p, unsigned v) { return __hip_atomic_fetch_add(p, v, __ATOMIC_RELAXED, __HIP_MEMORY_SCOPE_AGENT); }
__device__ __forceinline__ unsigned xb_xcc_id() { return (unsigned)__builtin_amdgcn_s_getreg((3 << 11) | 20) & 0xFu; }
#define XB_SPIN(cond, bar) do { unsigned _sp = 0; while (cond) { __builtin_amdgcn_s_sleep(1); \
    if ((++_sp & 255u) == 0u) { if (xb_ld(&(bar)[XB_TMO])) break; if (_sp > XB_SPIN_CAP) { atomicAdd(&(bar)[XB_TMO], 1u); break; } } } } while (0)

struct XcdBarrier {
    unsigned* bar; unsigned x;
    volatile LAS unsigned* st;
};

__device__ __forceinline__ XcdBarrier xcd_barrier_post(unsigned* bar, volatile LAS unsigned* st) {
    XcdBarrier b; b.bar = bar; b.x = xb_xcc_id(); b.st = st;
    if (threadIdx.x == 0) (void)xb_add(&bar[XB_XCNT(b.x)], 1u);
    return b;
}
__device__ __forceinline__ void xcd_barrier_complete(unsigned* bar, unsigned x, unsigned& nloc, unsigned& nx) {
    const unsigned G = gridDim.x * gridDim.y * gridDim.z;
    unsigned sum, cnt, mine, sp = 0u;
    for (;;) {
        sum = 0u; cnt = 0u; mine = 0u;
#pragma unroll
        for (unsigned j = 0; j < 16; ++j) { const unsigned c = xb_ld(&bar[XB_XCNT(j)]); sum += c; cnt += (c > 0u) ? 1u : 0u; mine = (j == x) ? c : mine; }
        if (sum == G) break;
        __builtin_amdgcn_s_sleep(1);
        if ((++sp & 255u) == 0u) { if (xb_ld(&bar[XB_TMO])) break; if (sp > XB_SPIN_CAP) { atomicAdd(&bar[XB_TMO], 1u); break; } }
    }
    nloc = mine > 0u ? mine : 1u; nx = cnt > 0u ? cnt : 1u;
}

__device__ __forceinline__ void xcd_barrier(const XcdBarrier& b) {
    asm volatile("s_waitcnt vmcnt(0)" ::: "memory");
    __syncthreads();
    if (threadIdx.x == 0) {
        unsigned* bar = b.bar;
        __builtin_amdgcn_s_waitcnt(0);
        unsigned nloc = b.st[0], nx = b.st[1];
        if (nloc == 0u) { xcd_barrier_complete(bar, b.x, nloc, nx); b.st[0] = nloc; b.st[1] = nx; }
        const unsigned old = xb_add(&bar[XB_XSUB(b.x)], 1u);
        const unsigned gen = old / nloc;
        if (old + 1u == (gen + 1u) * nloc) {
            __builtin_amdgcn_fence(__ATOMIC_RELEASE, "agent");
            asm volatile("s_waitcnt vmcnt(0)" ::: "memory");
            const unsigned og = xb_add(&bar[XB_TOP], 1u);
            const unsigned tg = og / nx;
            if (og + 1u == (tg + 1u) * nx) xb_add(&bar[XB_TOPGEN], 1u);
            else XB_SPIN(xb_ld(&bar[XB_TOPGEN]) == tg, bar);
            __builtin_amdgcn_fence(__ATOMIC_ACQUIRE, "agent");
            xb_add(&bar[XB_XGEN(b.x)], 1u);
            asm volatile("s_waitcnt vmcnt(0)" ::: "memory");
        } else {
            XB_SPIN(xb_ld(&bar[XB_XGEN(b.x)]) == gen, bar);
            __builtin_amdgcn_fence(__ATOMIC_ACQUIRE, "agent");
            asm volatile("s_waitcnt vmcnt(0)" ::: "memory");
        }
    }
    __syncthreads();
}

constexpr int CW_BAR = 4096;

struct Args { const float* in[24]; float* out; unsigned char* ws; int ph_lo, ph_hi; };

__device__ __forceinline__ void p0_transpose_item(const float* W, int K, int N, bf16_t* WT, int mode, const float* sc0, const float* sc1, int ksplit, LAS float* scr, int item, int lane) {
    const int nblk = N / 32, kb = item / nblk, nb = item % nblk, k0 = 64 * kb, n0 = 32 * nb;
#pragma unroll 8
    for (int i = 0; i < 32; ++i) { const int kk = 2 * i + (lane >> 5); scr[kk * 33 + (lane & 31)] = W[(size_t)(k0 + kk) * N + n0 + (lane & 31)]; }
    const int c = lane & 7;
    f32x4 sa = (f32x4){1.f, 1.f, 1.f, 1.f}, sb = sa;
    if (sc0) { const float* sp = (k0 < ksplit) ? (sc0 + k0) : (sc1 + (k0 - ksplit)); sa = *(const f32x4*)(sp + 8 * c); sb = *(const f32x4*)(sp + 8 * c + 4); }
    LDS_WAIT(); asm volatile("" ::: "memory");
#pragma unroll
    for (int j = 0; j < 4; ++j) { const int n = (lane >> 3) + 8 * j; const LAS float* s = scr + (8 * c) * 33 + n;
        u32x4 o; o.x = pk2(s[0 * 33] * sa[0], s[1 * 33] * sa[1]); o.y = pk2(s[2 * 33] * sa[2], s[3 * 33] * sa[3]); o.z = pk2(s[4 * 33] * sb[0], s[5 * 33] * sb[1]); o.w = pk2(s[6 * 33] * sb[2], s[7 * 33] * sb[3]);
        const int ng = n0 + n; const int row = (mode == 0) ? ng : (256 * (ng >> 7) + 128 * (mode - 1) + (ng & 127));
        *(u32x4*)(WT + (size_t)row * K + k0 + 8 * c) = o; }
    LDS_WAIT(); asm volatile("" ::: "memory");
}


__device__ __forceinline__ void cpowk(float lr, float li, float dt, int k, float& re, float& im) {
    const float mag = expf(lr * dt * (float)k), ang = li * dt * (float)k; re = mag * cosf(ang); im = mag * sinf(ang);
}
__device__ __forceinline__ void s5_co(float lr, float li, float dt, float& cor, float& coi) {
    float ar, ai; cpowk(lr, li, dt, 1, ar, ai);
    const float den = lr * lr + li * li, nr = ar - 1.0f, ni = ai; cor = (nr * lr + ni * li) / den; coi = (ni * lr - nr * li) / den;
}
struct S5P { const float *lam_re, *lam_im, *log_dt, *b_re, *b_im, *c_re, *c_im; };
__device__ __forceinline__ void p0_s5_kitem(const S5P& P, bf16_t* MQ, int g, int k, int lane) {
    const float dt = expf(P.log_dt[g]);
    float wr, wi; { const float lr = P.lam_re[g * 64 + lane], li = P.lam_im[g * 64 + lane]; float ar, ai, cor, coi; cpowk(lr, li, dt, k, ar, ai); s5_co(lr, li, dt, cor, coi); wr = ar * cor - ai * coi; wi = ar * coi + ai * cor; }
    const int kout = lane >> 2, h4 = (lane & 3) * 4;
    f32x4 acc = (f32x4){0.f, 0.f, 0.f, 0.f};
    for (int p = 0; p < 64; ++p) {
        const float pr = __shfl(wr, p), pi = __shfl(wi, p);
        const f32x4 br = *(const f32x4*)(P.b_re + (size_t)(g * 64 + p) * 16 + h4), bi = *(const f32x4*)(P.b_im + (size_t)(g * 64 + p) * 16 + h4);
        const float cr = P.c_re[(size_t)(g * 16 + kout) * 64 + p], ci = P.c_im[(size_t)(g * 16 + kout) * 64 + p];
        const f32x4 Wr = br * pr - bi * pi, Wi = bi * pr + br * pi;
        acc += Wr * cr - Wi * ci;
    }
    u32x2 w; w.x = pk2(acc[0], acc[1]); w.y = pk2(acc[2], acc[3]);
    bf16_t* base = MQ + (size_t)g * 256 * ASK;
    for (int tau = 0; tau + k < 16; ++tau) { const int t = tau + k;
        *(u32x2*)(base + (size_t)(t * 16 + kout) * ASK + tau * 16 + h4) = w;
        if (k > 0) *(u32x2*)(base + (size_t)(tau * 16 + kout) * ASK + t * 16 + h4) = (u32x2){0u, 0u}; }
}
__device__ __forceinline__ void p0_s5_qitem(const S5P& P, bf16_t* MQ, int g, int t, int lane) {
    const float dt = expf(P.log_dt[g]); const float lr = P.lam_re[g * 64 + lane], li = P.lam_im[g * 64 + lane];
    float ar, ai; cpowk(lr, li, dt, t + 1, ar, ai);
    bf16_t* base = MQ + ((size_t)g * 256 + t * 16) * ASK + 256 + lane;
#pragma unroll 4
    for (int kout = 0; kout < 16; ++kout) { const float cr = P.c_re[(size_t)(g * 16 + kout) * 64 + lane], ci = P.c_im[(size_t)(g * 16 + kout) * 64 + lane];
        base[(size_t)kout * ASK] = (bf16_t)f2bf(cr * ar - ci * ai); base[(size_t)kout * ASK + 64] = (bf16_t)f2bf(-(cr * ai + ci * ar)); }
}
__device__ __forceinline__ void p0_s5_pitem(const S5P& P, bf16_t* PT, float* A16, int g, int tau, int lane) {
    const float dt = expf(P.log_dt[g]); const float lr = P.lam_re[g * 64 + lane], li = P.lam_im[g * 64 + lane];
    float ar, ai, cor, coi; cpowk(lr, li, dt, 15 - tau, ar, ai); s5_co(lr, li, dt, cor, coi);
    const float wr = ar * cor - ai * coi, wi = ar * coi + ai * cor;
    const float* brp = P.b_re + (size_t)(g * 64 + lane) * 16; const float* bip = P.b_im + (size_t)(g * 64 + lane) * 16;
    unsigned re[8], im[8];
#pragma unroll
    for (int h = 0; h < 16; h += 2) { const float b0r = brp[h], b0i = bip[h], b1r = brp[h + 1], b1i = bip[h + 1];
        re[h >> 1] = pk2(wr * b0r - wi * b0i, wr * b1r - wi * b1i); im[h >> 1] = pk2(wr * b0i + wi * b0r, wr * b1i + wi * b1r); }
    bf16_t* r0 = PT + ((size_t)g * 128 + lane) * 256 + tau * 16; bf16_t* r1 = r0 + (size_t)64 * 256;
    *(u32x4*)(r0) = (u32x4){re[0], re[1], re[2], re[3]}; *(u32x4*)(r0 + 8) = (u32x4){re[4], re[5], re[6], re[7]};
    *(u32x4*)(r1) = (u32x4){im[0], im[1], im[2], im[3]}; *(u32x4*)(r1 + 8) = (u32x4){im[4], im[5], im[6], im[7]};
    if (tau == 0) { float a16r, a16i; cpowk(lr, li, dt, 16, a16r, a16i); A16[(g * 64 + lane) * 2] = a16r; A16[(g * 64 + lane) * 2 + 1] = a16i; }
}

__global__ void __launch_bounds__(NWAVES * 64, 2) mk_fwd(Args args) {
    extern __shared__ __attribute__((aligned(16))) unsigned char lds_raw[];
    LAS unsigned char* lds = (LAS unsigned char*)lds_raw;
    const int tid = threadIdx.x, lane = tid & 63, wave = __builtin_amdgcn_readfirstlane(tid >> 6);
    const int G = gridDim.x; const int bx = blockIdx.x; const int vcu = (G % 8 == 0) ? (bx % 8) * (G / 8) + bx / 8 : bx;
    unsigned char* ws = args.ws;
    const float* x = args.in[0]; float* out = args.out;
    bf16_t* Win_t = (bf16_t*)(ws + WS_WIN); bf16_t* Wout_t = (bf16_t*)(ws + WS_WOUT); bf16_t* Wgu_t = (bf16_t*)(ws + WS_WGU); bf16_t* Wd_t = (bf16_t*)(ws + WS_WD);
    bf16_t* XN = (bf16_t*)(ws + WS_XN); bf16_t* Ub = (bf16_t*)(ws + WS_U); bf16_t* Vb = (bf16_t*)(ws + WS_V); bf16_t* AS = (bf16_t*)(ws + WS_AS);
    bf16_t* MIX = (bf16_t*)(ws + WS_MIX); bf16_t* Hb = (bf16_t*)(ws + WS_H);
    float* LNST = (float*)(ws + WS_LNST); float* X1ST = (float*)(ws + WS_X1ST); float* X2ST = (float*)(ws + WS_X2ST); float* YAST = (float*)(ws + WS_YAST); float* YBST = (float*)(ws + WS_YBST);
    float* A16 = (float*)(ws + WS_A16); bf16_t* WM = (bf16_t*)(ws + WS_WM); bf16_t* MQ = (bf16_t*)(ws + WS_MQ); bf16_t* PT = (bf16_t*)(ws + WS_PT); float* Eb = (float*)(ws + WS_E);
    const int lo = args.ph_lo, hi = args.ph_hi;
    volatile LAS unsigned* MISC = (volatile LAS unsigned*)(lds + MISC_OFF);
    if (tid < 32) MISC[tid] = 0u;
    __syncthreads();
    XcdBarrier bar; bar.bar = (unsigned*)(ws + WS_CTL) + CW_BAR; bar.x = 0; bar.st = nullptr;
    if (hi - lo > 1) bar = xcd_barrier_post((unsigned*)(ws + WS_CTL) + CW_BAR, MISC + 8);
#define SEAM(k) do { if (IN(k) && IN((k) + 1)) xcd_barrier(bar); } while (0)
#ifndef PH_MASK
#define PH_MASK 0x1ff
#endif
#define IN(k) (((PH_MASK >> (k)) & 1) && lo <= (k) && (k) < hi)

    if (IN(0)) {
        LAS float* scr = (LAS float*)(lds + wave * 16384);
        const int gw = vcu * NWAVES + wave, NGW = G * NWAVES;
        constexpr int I_IN = (DM / 64) * (INW / 32), I_OUT = (DM / 64) * (DM / 32), I_G = (DM / 64) * (DFF / 32), I_D = (DFF / 64) * (DM / 32);
        constexpr int NITEMS = I_IN + I_OUT + 2 * I_G + I_D;
        for (int it = gw; it < NITEMS; it += NGW) {
            int r = it;
            if (r < I_IN) { p0_transpose_item(args.in[2], DM, INW, Win_t, 0, args.in[1], args.in[1], DM, scr, r, lane); continue; } r -= I_IN;
            if (r < I_OUT) { p0_transpose_item(args.in[18], DM, DM, Wout_t, 0, args.in[16], args.in[17], AW, scr, r, lane); continue; } r -= I_OUT;
            if (r < I_G) { p0_transpose_item(args.in[20], DM, DFF, Wgu_t, 1, args.in[19], args.in[19], DM, scr, r, lane); continue; } r -= I_G;
            if (r < I_G) { p0_transpose_item(args.in[21], DM, DFF, Wgu_t, 2, args.in[19], args.in[19], DM, scr, r, lane); continue; } r -= I_G;
            p0_transpose_item(args.in[22], DFF, DM, Wd_t, 0, nullptr, nullptr, 0, scr, r, lane);
        }
        for (int m = gw; m < SEQ; m += NGW) {
            const f32x4* xr = (const f32x4*)(x + (size_t)m * DM) + lane;
            f32x4 v[8]; float s = 0.f;
#pragma unroll
            for (int j = 0; j < 8; ++j) { v[j] = xr[64 * j]; s += (v[j].x * v[j].x + v[j].y * v[j].y) + (v[j].z * v[j].z + v[j].w * v[j].w); }
            const float r = 1.0f / sqrtf(wave_sum(s) * (1.0f / DM) + EPS);
            unsigned long long* o8 = (unsigned long long*)(XN + (size_t)m * DM) + lane;
#pragma unroll
            for (int j = 0; j < 8; ++j) o8[64 * j] = (unsigned long long)pk2(v[j].x * r, v[j].y * r) | ((unsigned long long)pk2(v[j].z * r, v[j].w * r) << 32);
        }

        {
            const S5P SP{args.in[7], args.in[8], args.in[9], args.in[10], args.in[11], args.in[12], args.in[13]};
            for (int it = gw; it < 3 * 1024 + 64; it += NGW) {
                if (it < 1024) p0_s5_kitem(SP, MQ, it >> 4, it & 15, lane);
                else if (it < 2048) p0_s5_qitem(SP, MQ, (it - 1024) >> 4, it & 15, lane);
                else if (it < 3072) p0_s5_pitem(SP, PT, A16, (it - 2048) >> 4, it & 15, lane);
                else { const int b = it - 3072; const float* wsrc = args.in[5] + (size_t)b * 2048;
                    for (int e = lane; e < 2048; e += 64) { const int i = ((b & 7) * 16) + (e >> 7), j = e & 127; WM[(size_t)b * 2048 + e] = (bf16_t)(((j >> 6) <= (i >> 6)) ? f2bf(wsrc[e]) : 0u); } }
            }
        }
    }

    SEAM(0);

    if (IN(1)) {
        pg8::Gemm g{XN, Win_t, SEQ, INW, DM}; pg8::StaticOrder S; S.init(SEQ, INW, G, bx);
        pg8::EpiIn E{Ub, Vb, AS, LNST};
        pg8::gemm_phase<pg8::EpiIn, pg8::StaticOrder, true, true>(lds, g, S, E);
    }


    SEAM(1);

    if (IN(2)) {
        typedef short bf16x8 __attribute__((ext_vector_type(8)));
        const float* lng = args.in[3]; const float* lnb = args.in[4]; const float* bsp = args.in[6];
        LAS bf16_t* vT = (LAS bf16_t*)lds;
        const int fr = lane & 15, fq = lane >> 4;
        for (int item = bx; item < 512; item += G) {
            const int n = item >> 3, h = item & 7;
            {
                const int p = tid >> 2, cq = tid & 3; const int row = n * 128 + p;
                float s = 0.f, ss = 0.f;
#pragma unroll
                for (int i = 0; i < 8; ++i) { const f32x4 t4 = *(const f32x4*)(LNST + (size_t)row * 32 + i * 4); s += t4[0] + t4[2]; ss += t4[1] + t4[3]; }
                const float mean = s * (1.0f / AW); const float rstd = 1.0f / sqrtf(ss * (1.0f / AW) - mean * mean + EPS);
#pragma unroll
                for (int c8 = 0; c8 < 4; ++c8) { const int cl = cq * 32 + c8 * 8; const int ch = h * 128 + cl;
                    const u32x4 vw = *(const u32x4*)(Vb + (size_t)row * AW + ch);
                    const f32x4 g0 = *(const f32x4*)(lng + ch), g1 = *(const f32x4*)(lng + ch + 4), b0 = *(const f32x4*)(lnb + ch), b1 = *(const f32x4*)(lnb + ch + 4);
                    float vv[8]; vv[0] = __builtin_bit_cast(float, vw.x << 16); vv[1] = __builtin_bit_cast(float, vw.x & 0xffff0000u); vv[2] = __builtin_bit_cast(float, vw.y << 16); vv[3] = __builtin_bit_cast(float, vw.y & 0xffff0000u);
                    vv[4] = __builtin_bit_cast(float, vw.z << 16); vv[5] = __builtin_bit_cast(float, vw.z & 0xffff0000u); vv[6] = __builtin_bit_cast(float, vw.w << 16); vv[7] = __builtin_bit_cast(float, vw.w & 0xffff0000u);
#pragma unroll
                    for (int e = 0; e < 8; ++e) { const float gg = e < 4 ? g0[e] : g1[e - 4], bb = e < 4 ? b0[e] : b1[e - 4];
                        vT[(cl + e) * 136 + p] = (bf16_t)f2bf((vv[e] - mean) * rstd * gg + bb); } }
            }
            __syncthreads();
            {
                f32x4 acc[8];
#pragma unroll
                for (int nt = 0; nt < 8; ++nt) acc[nt] = (f32x4){0.f, 0.f, 0.f, 0.f};
                const int nk = (wave < 4) ? 2 : 4;
                const bf16_t* wrow = WM + ((size_t)h * 128 + wave * 16 + fr) * 128 + 8 * fq;
                for (int kk = 0; kk < nk; ++kk) {
                    const bf16x8 bfr = *(const bf16x8*)(wrow + 32 * kk);
#pragma unroll
                    for (int nt = 0; nt < 8; ++nt) { const bf16x8 afr = *(const LAS bf16x8*)(vT + (16 * nt + fr) * 136 + 32 * kk + 8 * fq);
                        acc[nt] = __builtin_amdgcn_mfma_f32_16x16x32_bf16(afr, bfr, acc[nt], 0, 0, 0); }
                }
                const int pos = n * 128 + wave * 16 + fr; const float bsv = bsp[h * 128 + wave * 16 + fr]; float q = 0.f;
#pragma unroll
                for (int nt = 0; nt < 8; ++nt) { const int c0 = h * 128 + 16 * nt + 4 * fq;
                    const u32x2 uw = *(const u32x2*)(Ub + (size_t)pos * AW + c0);
                    const float y0 = __builtin_bit_cast(float, uw.x << 16) * (acc[nt][0] + bsv), y1 = __builtin_bit_cast(float, uw.x & 0xffff0000u) * (acc[nt][1] + bsv);
                    const float y2 = __builtin_bit_cast(float, uw.y << 16) * (acc[nt][2] + bsv), y3 = __builtin_bit_cast(float, uw.y & 0xffff0000u) * (acc[nt][3] + bsv);
                    u32x2 w; w.x = pg8::cvt_pk_bf16(y0, y1); w.y = pg8::cvt_pk_bf16(y2, y3);
                    *(u32x2*)(MIX + (size_t)pos * DM + c0) = w; q += (y0 * y0 + y1 * y1) + (y2 * y2 + y3 * y3); }
                q += __shfl_xor(q, 16); q += __shfl_xor(q, 32);
                if (fq == 0) YAST[(size_t)pos * 8 + h] = q;
            }
            __syncthreads();
        }
        const int gw = vcu * NWAVES + wave, NGW = G * NWAVES;
        for (int it = gw; it < 1024; it += NGW) {
            const int g = it >> 4, c0 = (it & 15) * 32;
            f32x4 acc[2][8];
#pragma unroll
            for (int mt = 0; mt < 2; ++mt)
#pragma unroll
                for (int nt = 0; nt < 8; ++nt) acc[mt][nt] = (f32x4){0.f, 0.f, 0.f, 0.f};
            const bf16_t* ap = AS + (size_t)(g * NCHUNK + c0 + fr) * ASK + 8 * fq; const bf16_t* bp = PT + (size_t)(g * 128 + fr) * 256 + 8 * fq;
#pragma unroll 2
            for (int ks = 0; ks < 8; ++ks) {
                const bf16x8 a0 = *(const bf16x8*)(ap + 32 * ks), a1 = *(const bf16x8*)(ap + (size_t)16 * ASK + 32 * ks);
#pragma unroll
                for (int nt = 0; nt < 8; ++nt) { const bf16x8 b = *(const bf16x8*)(bp + (size_t)(16 * nt) * 256 + 32 * ks);
                    acc[0][nt] = __builtin_amdgcn_mfma_f32_16x16x32_bf16(a0, b, acc[0][nt], 0, 0, 0); acc[1][nt] = __builtin_amdgcn_mfma_f32_16x16x32_bf16(a1, b, acc[1][nt], 0, 0, 0); }
            }
#pragma unroll
            for (int mt = 0; mt < 2; ++mt)
#pragma unroll
                for (int nt = 0; nt < 8; ++nt)
#pragma unroll
                    for (int r = 0; r < 4; ++r) Eb[(size_t)(g * NCHUNK + c0 + 16 * mt + 4 * fq + r) * 128 + 16 * nt + fr] = acc[mt][nt][r];
        }
    }

    SEAM(2);

    if (IN(3)) {
        if (wave == 0 && bx < NG) {
            const int g = bx; const float a16r = A16[(g * 64 + lane) * 2], a16i = A16[(g * 64 + lane) * 2 + 1];
            float sr = 0.f, si = 0.f;
            for (int c0 = 0; c0 < NCHUNK; c0 += 8) {
                float er[8], ei[8];
#pragma unroll
                for (int i = 0; i < 8; ++i) { er[i] = Eb[(size_t)(g * NCHUNK + c0 + i) * 128 + lane]; ei[i] = Eb[(size_t)(g * NCHUNK + c0 + i) * 128 + 64 + lane]; }
#pragma unroll
                for (int i = 0; i < 8; ++i) { bf16_t* sp = AS + (size_t)(g * NCHUNK + c0 + i) * ASK + 256 + lane;
                    sp[0] = (bf16_t)f2bf(sr); sp[64] = (bf16_t)f2bf(si);
                    const float nr = a16r * sr - a16i * si + er[i], ni = a16r * si + a16i * sr + ei[i]; sr = nr; si = ni; }
            }
        }
    }

    SEAM(3);

    if (IN(4)) {
        pg8::Gemm g{AS, MQ, NG * NCHUNK, 256, ASK}; pg8::S5Order S{G, bx};
        pg8::EpiS5 E{AS, args.in[14], args.in[15], MIX, YBST};
        pg8::gemm_phase<pg8::EpiS5, pg8::S5Order, false, true>(lds, g, S, E);
    }

    SEAM(4);

    if (IN(5)) {
        pg8::StaticOrder S; S.init(SEQ, DM, G, bx); pg8::Unit u0;
        if (S.next(0, u0) && tid < 256) {
            const int row = u0.pm * 256 + tid; float sa = 0.f, sb = 0.f;
            { const f32x4 a0 = *(const f32x4*)(YAST + (size_t)row * 8), a1 = *(const f32x4*)(YAST + (size_t)row * 8 + 4); sa = ((a0[0] + a0[1]) + (a0[2] + a0[3])) + ((a1[0] + a1[1]) + (a1[2] + a1[3])); }
#pragma unroll 4
            for (int i = 0; i < 16; ++i) { const f32x4 b4 = *(const f32x4*)(YBST + (size_t)row * 64 + i * 4); sb += (b4[0] + b4[1]) + (b4[2] + b4[3]); }
            const float ra = 1.0f / sqrtf(sa * (1.0f / AW) + EPS), rb = 1.0f / sqrtf(sb * (1.0f / BW) + EPS);
            ((LAS float*)(lds + pg8::XT_RHO))[tid] = ra / rb; ((LAS float*)(lds + pg8::XT_RB))[tid] = rb;
        }
        __syncthreads();
        pg8::Gemm g{MIX, Wout_t, SEQ, DM, DM};
        pg8::EpiOut E{x, out, XN  , X1ST};
        pg8::gemm_phase<pg8::EpiOut, pg8::StaticOrder, false, true>(lds, g, S, E);
    }

    SEAM(5);

    if (IN(6)) {
        pg8::Gemm g{XN, Wgu_t, SEQ, 2 * DFF, DM}; pg8::StaticOrder S; S.init(SEQ, 2 * DFF, G, bx);
        pg8::EpiGU E{Hb, X1ST};
        pg8::gemm_phase<pg8::EpiGU, pg8::StaticOrder, true, true>(lds, g, S, E);
    }

    SEAM(6);

    if (IN(7)) {
        pg8::Gemm g{Hb, Wd_t, SEQ, DM, DFF}; pg8::StaticOrder S; S.init(SEQ, DM, G, bx);
        pg8::EpiDown E{out, X2ST};
        pg8::gemm_phase<pg8::EpiDown, pg8::StaticOrder, false, true>(lds, g, S, E);
    }

    SEAM(7);

    if (IN(8)) {
        const int gw = vcu * NWAVES + wave, NGW = G * NWAVES; const float* gf = args.in[23];
        for (int m = gw; m < SEQ; m += NGW) {
            const f32x4 s0 = *(const f32x4*)(X2ST + (size_t)m * 8), s1 = *(const f32x4*)(X2ST + (size_t)m * 8 + 4);
            const float r = 1.0f / sqrtf((((s0[0] + s0[1]) + (s0[2] + s0[3])) + ((s1[0] + s1[1]) + (s1[2] + s1[3]))) * (1.0f / DM) + EPS);
            f32x4* xr = (f32x4*)(out + (size_t)m * DM) + lane; const f32x4* gr = (const f32x4*)gf + lane;
#pragma unroll
            for (int j = 0; j < 8; ++j) { f32x4 v = xr[64 * j]; const f32x4 gg = gr[64 * j]; xr[64 * j] = v * r * gg; }
        }
    }
#undef IN
}

extern "C" void kernel_launch(void* const* d_in, const int* in_sizes, int n_in, void* d_out, int out_size, void* d_ws, size_t ws_size, hipStream_t stream) {
    static int grid = 0;
    if (grid == 0) {
        if (n_in != 24 || in_sizes[0] != SEQ * DM || out_size != SEQ * DM || ws_size < WS_END) { fprintf(stderr, "kernel_launch: unexpected shapes (n_in %d, in0 %d, out %d, ws %zu)\n", n_in, n_in > 0 ? in_sizes[0] : -1, out_size, ws_size); grid = -1; return; }
        int dev = 0, cus = 0;
        if (hipGetDevice(&dev) != hipSuccess || hipDeviceGetAttribute(&cus, hipDeviceAttributeMultiprocessorCount, dev) != hipSuccess) { grid = -1; return; }
        if (hipFuncSetAttribute((const void*)mk_fwd, hipFuncAttributeMaxDynamicSharedMemorySize, LDS_BYTES) != hipSuccess) { fprintf(stderr, "kernel_launch: hipFuncSetAttribute failed\n"); grid = -1; return; }
        (void)hipGetLastError();
        grid = cus;
    }
    if (grid < 0) return;
    Args a{};
    for (int i = 0; i < 24; ++i) a.in[i] = (const float*)d_in[i];
    a.out = (float*)d_out; a.ws = (unsigned char*)d_ws;
    auto run = [&](int lo, int hi) { a.ph_lo = lo; a.ph_hi = hi; hipLaunchKernelGGL(mk_fwd, dim3(grid), dim3(NWAVES * 64), LDS_BYTES, stream, a); };
#ifndef MK_N_LAUNCHES
#define MK_N_LAUNCHES 1
#endif
#if MK_N_LAUNCHES == 1
    if (hipMemsetAsync((char*)d_ws + WS_CTL, 0, 32768, stream) != hipSuccess) { fprintf(stderr, "kernel_launch: hipMemsetAsync failed\n"); return; }
    run(0, 9);
#else
    for (int p = 0; p < 9; ++p) run(p, p + 1);
#endif
}
```

```cpp
#include <hip/hip_runtime.h>
#include <cstdio>
#include <cstdint>
#include <cmath>
namespace pg8 {
#define PG8_LAS __attribute__((address_space(3)))
typedef unsigned short bf16_t;
typedef short bf16x8 __attribute__((ext_vector_type(8)));
typedef float f32x4 __attribute__((ext_vector_type(4)));
typedef unsigned u32x4 __attribute__((ext_vector_type(4)));
constexpr int BM = 256, BK = 64, HALF = 128, HTB = HALF * BK * 2  , STAGE_BYTES = 8 * HTB, NXCD = 8, WGM = 8;

__host__ __device__ __forceinline__ int lds_byte(int r, int c) { const int st = (r >> 4) * 2 + (c >> 5), rr = r & 15, cc = c & 31, ob = rr * 64 + cc * 2; return st * 1024 + (ob ^ (((ob >> 9) & 1) << 5)); }
__host__ __device__ __forceinline__ void stage_rc(int b, int& R, int& C) { const int st = b / 1024, sb = b % 1024, swz = sb ^ (((sb >> 9) & 1) << 5); R = (st >> 1) * 16 + swz / 64; C = (st & 1) * 32 + (swz % 64) / 2; }
__host__ __device__ __forceinline__ int perm32(int rho) { const int n = rho >> 4, i = rho & 15; return 8 * (i >> 2) + 4 * n + (i & 3); }

struct Unit { int pm, pn; };
struct Gemm { const bf16_t* A; const bf16_t* Bt; int M, N, K; };

struct StaticOrder {
    int nM, nN, nwg, G, c;
    __host__ __device__ void init(int M, int N, int G_, int c_) { nM = M / BM; nN = N / BM; nwg = nM * nN; G = G_; c = c_; }
    __host__ __device__ bool next(int i, Unit& u) const {
        const long L = (long)i * G + c; if (L >= nwg) return false;
        int wgid = (int)L; { const int q = nwg / NXCD, r = nwg % NXCD, xcd = wgid % NXCD, off = wgid / NXCD; wgid = (xcd < r ? xcd * (q + 1) : r * (q + 1) + (xcd - r) * q) + off; }
        const int nig = WGM * nN, gid = wgid / nig, fm = gid * WGM, gsz = (nM - fm) < WGM ? (nM - fm) : WGM;
        u.pm = fm + ((wgid % nig) % gsz); u.pn = (wgid % nig) / gsz; return true;
    }
    __device__ __forceinline__ void a_ready(const Unit&) const {}
    __device__ __forceinline__ void done(const Unit&) const {}
};

__device__ __forceinline__ unsigned cvt_pk_bf16(float lo, float hi) { unsigned r; asm volatile("v_cvt_pk_bf16_f32 %0, %1, %2" : "=v"(r) : "v"(lo), "v"(hi)); return r; }
typedef float f32x2 __attribute__((ext_vector_type(2)));
__device__ __forceinline__ f32x2 gelu_pk(f32x2 v) {
    const f32x2 av = __builtin_elementwise_abs(v), d = av * 0.2316418882f + 1.0f;
    f32x2 t; t.x = __builtin_amdgcn_rcpf(d.x); t.y = __builtin_amdgcn_rcpf(d.y);
    f32x2 q = t * 0.5307027145f + (-0.7265760135f); q = q * t + 0.7107068705f; q = q * t + (-0.142248368f); q = q * t + 0.127414796f; q = q * t;
    const f32x2 s = (v * v) * (-0.72134752044f);
    f32x2 e; e.x = __builtin_amdgcn_exp2f(s.x); e.y = __builtin_amdgcn_exp2f(s.y);
    const f32x2 m = v * (q * e), r = v - m;
    f32x2 o; o.x = v.x < 0.f ? m.x : r.x; o.y = v.y < 0.f ? m.y : r.y; return o;
}


typedef unsigned u32x2 __attribute__((ext_vector_type(2)));
typedef __bf16 bf16x2_t __attribute__((ext_vector_type(2)));
__device__ __forceinline__ unsigned cvtpk_s(float lo, float hi) { f32x2 v = {lo, hi}; bf16x2_t b = __builtin_convertvector(v, bf16x2_t); return __builtin_bit_cast(unsigned, b); }
constexpr int XT_OFF = 131072;
constexpr int XT_RHO = XT_OFF, XT_RB = XT_OFF + 1024;
constexpr int P_SEQ = 8192, P_DM = 2048, P_AW = 1024, P_DFF = 5632, P_NCHUNK = 512, P_ASK = 384;
constexpr float P_EPS = 1e-6f;

struct EpiIn {
    static constexpr bool PERM = true, AFTER_DRAIN = false, MIDK = false;
    bf16_t* U; bf16_t* V; bf16_t* AS; float* LNST;
    __device__ __forceinline__ void operator()(const f32x4 (&acc)[2][2][4][2], const Unit& u, int wr, int wc, int fr, int fq) const {
        const int kind = u.pn >> 2;
        const int row0 = u.pm * BM + wr * 64 + fr;
        const int colt = (u.pn & 3) * BM + wc * 32 + 8 * fq;
        if (kind == 2) {
#pragma unroll
            for (int ai = 0; ai < 2; ++ai)
#pragma unroll
                for (int m = 0; m < 4; ++m) { const int row = row0 + ai * HALF + m * 16; const int chunk = row >> 4, t = row & 15;
#pragma unroll
                    for (int bj = 0; bj < 2; ++bj) { const int cs = colt + bj * HALF; const int g = cs >> 4, c8 = cs & 15;
                        const f32x4 v0 = acc[ai][bj][m][0], v1 = acc[ai][bj][m][1];
                        u32x4 w; w.x = cvt_pk_bf16(v0[0], v0[1]); w.y = cvt_pk_bf16(v0[2], v0[3]); w.z = cvt_pk_bf16(v1[0], v1[1]); w.w = cvt_pk_bf16(v1[2], v1[3]);
                        *(u32x4*)(AS + ((size_t)(g * P_NCHUNK + chunk) * P_ASK + t * 16 + c8)) = w; } }
        } else {
            bf16_t* base = (kind == 0) ? U : V;
#pragma unroll
            for (int ai = 0; ai < 2; ++ai)
#pragma unroll
                for (int m = 0; m < 4; ++m) { const int row = row0 + ai * HALF + m * 16; float s = 0.f, ss = 0.f;
#pragma unroll
                    for (int bj = 0; bj < 2; ++bj) { f32x4 v0 = acc[ai][bj][m][0], v1 = acc[ai][bj][m][1];
                        const f32x2 a = gelu_pk((f32x2){v0[0], v0[1]}), b = gelu_pk((f32x2){v0[2], v0[3]}), c = gelu_pk((f32x2){v1[0], v1[1]}), d = gelu_pk((f32x2){v1[2], v1[3]});
                        s += ((a.x + a.y) + (b.x + b.y)) + ((c.x + c.y) + (d.x + d.y));
                        ss += ((a.x * a.x + a.y * a.y) + (b.x * b.x + b.y * b.y)) + ((c.x * c.x + c.y * c.y) + (d.x * d.x + d.y * d.y));
                        u32x4 w; w.x = cvt_pk_bf16(a.x, a.y); w.y = cvt_pk_bf16(b.x, b.y); w.z = cvt_pk_bf16(c.x, c.y); w.w = cvt_pk_bf16(d.x, d.y);
                        *(u32x4*)(base + (size_t)row * P_AW + colt + bj * HALF) = w; }
                    if (kind == 1) { s += __shfl_xor(s, 16); s += __shfl_xor(s, 32); ss += __shfl_xor(ss, 16); ss += __shfl_xor(ss, 32);
                        if (fq == 0) *(f32x2*)(LNST + ((size_t)row * 16 + (u.pn & 3) * 4 + wc) * 2) = (f32x2){s, ss}; } }
        }
    }
};

struct EpiOut {
    static constexpr bool PERM = false, AFTER_DRAIN = true, MIDK = true;
    const float* x; float* out; bf16_t* X1B; float* X1ST;
    __device__ __forceinline__ void midk(f32x4 (&acc)[2][2][4][2], int wr, int fr, PG8_LAS unsigned char* lds) const {
        const PG8_LAS float* RHO = (const PG8_LAS float*)(lds + XT_RHO);
#pragma unroll
        for (int ai = 0; ai < 2; ++ai)
#pragma unroll
            for (int m = 0; m < 4; ++m) { const float r = RHO[ai * HALF + wr * 64 + m * 16 + fr];
#pragma unroll
                for (int bj = 0; bj < 2; ++bj)
#pragma unroll
                    for (int n = 0; n < 2; ++n) acc[ai][bj][m][n] = acc[ai][bj][m][n] * r; }
    }
    __device__ __forceinline__ void fused(f32x4 (&acc)[2][2][4][2], const Unit& u, int wr, int wc, int fr, int fq, PG8_LAS unsigned char* lds, int wid, int lane) const {
        const PG8_LAS float* RB = (const PG8_LAS float*)(lds + XT_RB);
        PG8_LAS float* P = (PG8_LAS float*)lds;
        const int col0 = u.pn * BM + wc * 32 + 4 * fq;
#pragma unroll
        for (int ai = 0; ai < 2; ++ai)
#pragma unroll
            for (int m = 0; m < 4; ++m) { const int r = ai * HALF + wr * 64 + m * 16 + fr; const float rb = RB[r]; const size_t off = (size_t)(u.pm * BM + r) * P_DM + col0; float q = 0.f;
#pragma unroll
                for (int bj = 0; bj < 2; ++bj)
#pragma unroll
                    for (int n = 0; n < 2; ++n) { const f32x4 xv = *(const f32x4*)(x + off + bj * HALF + n * 16); const f32x4 o = xv + acc[ai][bj][m][n] * rb;
                        *(f32x4*)(out + off + bj * HALF + n * 16) = o;
                        u32x2 w; w.x = cvt_pk_bf16(o[0], o[1]); w.y = cvt_pk_bf16(o[2], o[3]); *(u32x2*)(X1B + off + bj * HALF + n * 16) = w;
                        q += (o[0] * o[0] + o[1] * o[1]) + (o[2] * o[2] + o[3] * o[3]); }
                q += __shfl_xor(q, 16); q += __shfl_xor(q, 32);
                if (fq == 0) P[r * 4 + wc] = q;
                if (m & 1) asm volatile("" ::: "memory"); }
        asm volatile("s_waitcnt lgkmcnt(0)" ::: "memory"); __builtin_amdgcn_s_barrier(); asm volatile("" ::: "memory");
        const int t = wid * 64 + lane;
        if (t < 256) X1ST[(size_t)(u.pm * BM + t) * 8 + u.pn] = (P[t * 4 + 0] + P[t * 4 + 1]) + (P[t * 4 + 2] + P[t * 4 + 3]);
    }
};

struct EpiGU {
    static constexpr bool PERM = true, AFTER_DRAIN = false, MIDK = false;
    bf16_t* H; const float* X1ST;
    __device__ __forceinline__ void operator()(const f32x4 (&acc)[2][2][4][2], const Unit& u, int wr, int wc, int fr, int fq) const {
        const int row0 = u.pm * BM + wr * 64 + fr; const int col0 = u.pn * HALF + wc * 32 + 8 * fq;
#pragma unroll
        for (int ai = 0; ai < 2; ++ai)
#pragma unroll
            for (int m = 0; m < 4; ++m) { const int row = row0 + ai * HALF + m * 16;
                const f32x4 s0 = *(const f32x4*)(X1ST + (size_t)row * 8), s1 = *(const f32x4*)(X1ST + (size_t)row * 8 + 4);
                const float r = __builtin_amdgcn_rsqf((((s0[0] + s0[1]) + (s0[2] + s0[3])) + ((s1[0] + s1[1]) + (s1[2] + s1[3]))) * (1.0f / P_DM) + P_EPS);
                float hv[8];
#pragma unroll
                for (int n = 0; n < 2; ++n)
#pragma unroll
                    for (int j = 0; j < 4; ++j) { const float g = acc[ai][0][m][n][j] * r, up = acc[ai][1][m][n][j] * r;
                        const float e = __builtin_amdgcn_exp2f(g * (-1.4426950408889634f)); hv[n * 4 + j] = g * __builtin_amdgcn_rcpf(1.0f + e) * up; }
                u32x4 w; w.x = cvt_pk_bf16(hv[0], hv[1]); w.y = cvt_pk_bf16(hv[2], hv[3]); w.z = cvt_pk_bf16(hv[4], hv[5]); w.w = cvt_pk_bf16(hv[6], hv[7]);
                *(u32x4*)(H + (size_t)row * P_DFF + col0) = w; }
    }
};

struct EpiDown {
    static constexpr bool PERM = false, AFTER_DRAIN = true, MIDK = false;
    float* out; float* X2ST;
    __device__ __forceinline__ void fused(f32x4 (&acc)[2][2][4][2], const Unit& u, int wr, int wc, int fr, int fq, PG8_LAS unsigned char* lds, int wid, int lane) const {
        PG8_LAS float* P = (PG8_LAS float*)lds;
        const int col0 = u.pn * BM + wc * 32 + 4 * fq;
#pragma unroll
        for (int ai = 0; ai < 2; ++ai)
#pragma unroll
            for (int m = 0; m < 4; ++m) { const int r = ai * HALF + wr * 64 + m * 16 + fr; const size_t off = (size_t)(u.pm * BM + r) * P_DM + col0; float q = 0.f;
#pragma unroll
                for (int bj = 0; bj < 2; ++bj)
#pragma unroll
                    for (int n = 0; n < 2; ++n) { const f32x4 xv = *(const f32x4*)(out + off + bj * HALF + n * 16); const f32x4 o = xv + acc[ai][bj][m][n];
                        *(f32x4*)(out + off + bj * HALF + n * 16) = o; q += (o[0] * o[0] + o[1] * o[1]) + (o[2] * o[2] + o[3] * o[3]); }
                q += __shfl_xor(q, 16); q += __shfl_xor(q, 32);
                if (fq == 0) P[r * 4 + wc] = q;
                if (m & 1) asm volatile("" ::: "memory"); }
        asm volatile("s_waitcnt lgkmcnt(0)" ::: "memory"); __builtin_amdgcn_s_barrier(); asm volatile("" ::: "memory");
        const int t = wid * 64 + lane;
        if (t < 256) X2ST[(size_t)(u.pm * BM + t) * 8 + u.pn] = (P[t * 4 + 0] + P[t * 4 + 1]) + (P[t * 4 + 2] + P[t * 4 + 3]);
    }
};

struct S5Order {
    int G, c;
    __device__ bool next(int i, Unit& u) const { const int L = i * G + c; if (L >= 128) return false; u.pm = L; u.pn = L >> 1; return true; }
    __device__ __forceinline__ void a_ready(const Unit&) const {}
    __device__ __forceinline__ void done(const Unit&) const {}
};
typedef short bf16x4 __attribute__((ext_vector_type(4)));
struct EpiS5 {
    static constexpr bool PERM = false, AFTER_DRAIN = true, MIDK = false;
    const bf16_t* AS; const float* dvec; const float* wglu; bf16_t* MIX; float* YBST;
    __device__ __forceinline__ void fused(f32x4 (&acc)[2][2][4][2], const Unit& u, int wr, int wc, int fr, int fq, PG8_LAS unsigned char* lds, int wid, int lane) const {
        const int g = u.pn; const int chunk0 = (u.pm & 1) * 256 + wr * 64 + fr;
        bf16x4 wf; { const float* wp = wglu + (size_t)(g * 16 + 4 * fq) * 16 + fr;
            const unsigned a = cvtpk_s(wp[0], wp[16]), b = cvtpk_s(wp[32], wp[48]); wf = __builtin_bit_cast(bf16x4, (u32x2){a, b}); }
        const f32x4 dv = *(const f32x4*)(dvec + g * 16 + 4 * fq);
#pragma unroll
        for (int ai = 0; ai < 2; ++ai) {
            u32x2 uw[4][2][2];
#pragma unroll
            for (int m = 0; m < 4; ++m) { const bf16_t* arow = AS + (size_t)(g * P_NCHUNK + chunk0 + ai * HALF + m * 16) * P_ASK + 4 * fq;
#pragma unroll
                for (int bj = 0; bj < 2; ++bj)
#pragma unroll
                    for (int n = 0; n < 2; ++n) uw[m][bj][n] = *(const u32x2*)(arow + (8 * bj + 2 * wc + n) * 16); }
            asm volatile("" ::: "memory");
#pragma unroll
            for (int m = 0; m < 4; ++m) { const int chunk = chunk0 + ai * HALF + m * 16;
#pragma unroll
                for (int bj = 0; bj < 2; ++bj)
#pragma unroll
                    for (int n = 0; n < 2; ++n) { const int t = 8 * bj + 2 * wc + n; const int pos = chunk * 16 + t;
                        const u32x2 w2 = uw[m][bj][n];
                        f32x4 y = acc[ai][bj][m][n];
                        y[0] += dv[0] * __builtin_bit_cast(float, w2.x << 16); y[1] += dv[1] * __builtin_bit_cast(float, w2.x & 0xffff0000u);
                        y[2] += dv[2] * __builtin_bit_cast(float, w2.y << 16); y[3] += dv[3] * __builtin_bit_cast(float, w2.y & 0xffff0000u);
                        const f32x2 ya = gelu_pk((f32x2){y[0], y[1]}), yb = gelu_pk((f32x2){y[2], y[3]});
                        const bf16x4 yf = __builtin_bit_cast(bf16x4, (u32x2){cvtpk_s(ya.x, ya.y), cvtpk_s(yb.x, yb.y)});
                        const f32x4 z = __builtin_amdgcn_mfma_f32_16x16x16bf16_1k(wf, yf, (f32x4){0.f, 0.f, 0.f, 0.f}, 0, 0, 0);
                        f32x4 o;
                        o[0] = ya.x * __builtin_amdgcn_rcpf(1.0f + __builtin_amdgcn_exp2f(z[0] * (-1.4426950408889634f)));
                        o[1] = ya.y * __builtin_amdgcn_rcpf(1.0f + __builtin_amdgcn_exp2f(z[1] * (-1.4426950408889634f)));
                        o[2] = yb.x * __builtin_amdgcn_rcpf(1.0f + __builtin_amdgcn_exp2f(z[2] * (-1.4426950408889634f)));
                        o[3] = yb.y * __builtin_amdgcn_rcpf(1.0f + __builtin_amdgcn_exp2f(z[3] * (-1.4426950408889634f)));
                        u32x2 w; w.x = cvt_pk_bf16(o[0], o[1]); w.y = cvt_pk_bf16(o[2], o[3]);
                        *(u32x2*)(MIX + (size_t)pos * P_DM + P_AW + g * 16 + 4 * fq) = w;
                        float q = (o[0] * o[0] + o[1] * o[1]) + (o[2] * o[2] + o[3] * o[3]);
                        q += __shfl_xor(q, 16); q += __shfl_xor(q, 32);
                        if (fq == 0) YBST[(size_t)pos * 64 + g] = q; } }
            asm volatile("" ::: "memory"); }
    }
};
template <class Epi, class Sched, bool ALIGN_EPI = false, bool SP2 = false>
__device__ __forceinline__ void gemm_phase(PG8_LAS unsigned char* lds, const Gemm g, const Sched& S, const Epi& E) {
    const int tid = threadIdx.x, wid = __builtin_amdgcn_readfirstlane(tid >> 6), lane = tid & 63, wr = wid >> 2, wc = wid & 3, fr = lane & 15, fq = lane >> 4;
    const int K = g.K, nt = K / BK;
    unsigned voffA[2], voffB[2];
#pragma unroll
    for (int i = 0; i < 2; ++i) { int R, C; stage_rc(tid * 16 + i * 8192, R, C); const int Rb = Epi::PERM ? ((R & ~31) + perm32(R & 31)) : R;
        voffA[i] = (unsigned)(R * K + C) * 2u; voffB[i] = (unsigned)(Rb * K + C) * 2u; }
    const size_t kstep = (size_t)(BK * 2);
    const size_t hstep = (size_t)HALF * K * 2;
    const size_t tstep = 2 * hstep;
    const unsigned ldsw = (unsigned)wid * 1024u;
    const int aoff = lds_byte(wr * 64 + fr, fq * 8), boff = lds_byte(wc * 32 + fr, fq * 8);
#define PG8_SA(b, h) (((b) * 2 + (h)) * HTB)
#define PG8_SB(b, h) ((4 + (b) * 2 + (h)) * HTB)
#define PG8_STAGE(bufoff, gbase, voff) do { _Pragma("unroll") for (int _i = 0; _i < 2; ++_i) \
        __builtin_amdgcn_global_load_lds((const unsigned*)((const char*)(gbase) + (voff)[_i]), (PG8_LAS unsigned*)(lds + (bufoff) + ldsw + _i * 8192), 16, 0, 0); } while (0)
#define PG8_LDA(dst, b, h) do { _Pragma("unroll") for (int m = 0; m < 4; ++m) _Pragma("unroll") for (int k = 0; k < 2; ++k) dst[m][k] = *(const PG8_LAS bf16x8*)(lds + PG8_SA(b, h) + aoff + m * 2048 + k * 1024); } while (0)
#define PG8_LDB(dst, b, h) do { _Pragma("unroll") for (int n = 0; n < 2; ++n) _Pragma("unroll") for (int k = 0; k < 2; ++k) dst[n][k] = *(const PG8_LAS bf16x8*)(lds + PG8_SB(b, h) + boff + n * 2048 + k * 1024); } while (0)
#define PG8_MMA(ai, bj, At, Bt) do { __builtin_amdgcn_s_setprio(1); _Pragma("unroll") for (int m = 0; m < 4; ++m) _Pragma("unroll") for (int n = 0; n < 2; ++n) _Pragma("unroll") for (int k = 0; k < 2; ++k) \
        acc[ai][bj][m][n] = __builtin_amdgcn_mfma_f32_16x16x32_bf16(Bt[n][k], At[m][k], acc[ai][bj][m][n], 0, 0, 0); __builtin_amdgcn_s_setprio(0); } while (0)
#define PG8_WAIT_V(n) asm volatile("s_waitcnt vmcnt(" #n ")" ::: "memory")
#define PG8_WAIT_L(n) asm volatile("s_waitcnt lgkmcnt(" #n ")" ::: "memory")
#define PG8_BAR __builtin_amdgcn_s_barrier()
#define PG8_SCHED __builtin_amdgcn_sched_barrier(0)
    Unit cur, nxt; int ui = 0;
    if (!S.next(0, cur)) return;
    f32x4 acc[2][2][4][2];
#pragma unroll
    for (int a = 0; a < 2; ++a)
#pragma unroll
        for (int b = 0; b < 2; ++b)
#pragma unroll
            for (int m = 0; m < 4; ++m)
#pragma unroll
                for (int n = 0; n < 2; ++n) acc[a][b][m][n] = (f32x4){0.f, 0.f, 0.f, 0.f};
    bf16x8 At[4][2], B0[2][2], B1[2][2];
    const char* cA = (const char*)g.A + (size_t)cur.pm * tstep; const char* cB = (const char*)g.Bt + (size_t)cur.pn * tstep;
    S.a_ready(cur);
    if constexpr (SP2) {
        PG8_STAGE(PG8_SB(0, 0), cB, voffB); PG8_STAGE(PG8_SB(0, 1), cB + hstep, voffB); PG8_STAGE(PG8_SA(0, 0), cA, voffA); PG8_STAGE(PG8_SA(0, 1), cA + hstep, voffA);
        if (wr == 1) PG8_BAR;
        PG8_WAIT_V(2); PG8_BAR;
        PG8_STAGE(PG8_SB(1, 0), cB + kstep, voffB); PG8_STAGE(PG8_SA(1, 0), cA + kstep, voffA); PG8_STAGE(PG8_SB(1, 1), cB + hstep + kstep, voffB);
        PG8_WAIT_V(6); PG8_BAR;
    } else {
        PG8_STAGE(PG8_SB(0, 0), cB, voffB); PG8_STAGE(PG8_SA(0, 0), cA, voffA); PG8_STAGE(PG8_SB(0, 1), cB + hstep, voffB); PG8_STAGE(PG8_SA(0, 1), cA + hstep, voffA);
        if (wr == 1) PG8_BAR;
        PG8_WAIT_V(4); PG8_BAR;
        PG8_STAGE(PG8_SB(1, 0), cB + kstep, voffB); PG8_STAGE(PG8_SA(1, 0), cA + kstep, voffA); PG8_STAGE(PG8_SB(1, 1), cB + hstep + kstep, voffB);
        PG8_WAIT_V(6); PG8_BAR;
    }
    for (;;) {
        const bool has_next = S.next(ui + 1, nxt);
        const char* nA = has_next ? (const char*)g.A + (size_t)nxt.pm * tstep : cA; const char* nB = has_next ? (const char*)g.Bt + (size_t)nxt.pn * tstep : cB;
        for (int t = 0; t < nt; t += 2) {
            const bool last = (t == nt - 2);
            if constexpr (Epi::MIDK) { if (t == (nt >> 1)) E.midk(acc, wr, fr, lds); }
            const char* a1 = cA + (size_t)(t + 1) * kstep;
            const char* a2 = last ? nA : cA + (size_t)(t + 2) * kstep; const char* b2 = last ? nB : cB + (size_t)(t + 2) * kstep;
            const char* a3 = a2 + kstep; const char* b3 = b2 + kstep;
            if (last && has_next) S.a_ready(nxt);
            if constexpr (SP2) {
            PG8_LDB(B0, 0, 0); PG8_LDB(B1, 0, 1); PG8_SCHED; PG8_LDA(At, 0, 0); PG8_STAGE(PG8_SA(1, 1), a1 + hstep, voffA);
            PG8_WAIT_V(8); PG8_WAIT_L(0); PG8_BAR; PG8_MMA(0, 0, At, B0); PG8_MMA(0, 1, At, B1); PG8_BAR; PG8_SCHED;
            PG8_LDA(At, 0, 1); PG8_STAGE(PG8_SB(0, 0), b2, voffB); PG8_STAGE(PG8_SB(0, 1), b2 + hstep, voffB); PG8_STAGE(PG8_SA(0, 0), a2, voffA);
            PG8_WAIT_V(8); PG8_WAIT_L(0); PG8_BAR; PG8_MMA(1, 0, At, B0); PG8_MMA(1, 1, At, B1); PG8_BAR; PG8_SCHED;
            PG8_LDB(B0, 1, 0); PG8_LDB(B1, 1, 1); PG8_SCHED; PG8_LDA(At, 1, 0); PG8_STAGE(PG8_SA(0, 1), a2 + hstep, voffA);
            PG8_WAIT_V(8); PG8_WAIT_L(0); PG8_BAR; PG8_MMA(0, 0, At, B0); PG8_MMA(0, 1, At, B1); PG8_BAR; PG8_SCHED;
            PG8_LDA(At, 1, 1); PG8_STAGE(PG8_SB(1, 0), b3, voffB); PG8_STAGE(PG8_SB(1, 1), b3 + hstep, voffB); PG8_STAGE(PG8_SA(1, 0), a3, voffA);
            PG8_WAIT_V(8); PG8_WAIT_L(0); PG8_BAR; PG8_MMA(1, 0, At, B0); PG8_MMA(1, 1, At, B1); PG8_BAR; PG8_SCHED;
            } else {
            PG8_LDB(B0, 0, 0); PG8_SCHED; PG8_LDA(At, 0, 0); PG8_STAGE(PG8_SA(1, 1), a1 + hstep, voffA);
            PG8_WAIT_L(8); PG8_BAR; PG8_WAIT_L(0); PG8_MMA(0, 0, At, B0); PG8_BAR; PG8_SCHED;
            PG8_LDB(B1, 0, 1); PG8_STAGE(PG8_SB(0, 0), b2, voffB);
            PG8_BAR; PG8_WAIT_L(0); PG8_MMA(0, 1, At, B1); PG8_BAR;
            PG8_LDA(At, 0, 1); PG8_STAGE(PG8_SA(0, 0), a2, voffA);
            PG8_BAR; PG8_WAIT_L(0); PG8_MMA(1, 0, At, B0); PG8_BAR; PG8_SCHED;
            PG8_STAGE(PG8_SB(0, 1), b2 + hstep, voffB);
            PG8_WAIT_V(6); PG8_BAR; PG8_MMA(1, 1, At, B1); PG8_BAR;
            PG8_LDB(B0, 1, 0); PG8_SCHED; PG8_LDA(At, 1, 0); PG8_STAGE(PG8_SA(0, 1), a2 + hstep, voffA);
            PG8_WAIT_L(8); PG8_BAR; PG8_WAIT_L(0); PG8_MMA(0, 0, At, B0); PG8_BAR; PG8_SCHED;
            PG8_LDB(B1, 1, 1); PG8_STAGE(PG8_SB(1, 0), b3, voffB);
            PG8_BAR; PG8_WAIT_L(0); PG8_MMA(0, 1, At, B1); PG8_BAR;
            PG8_LDA(At, 1, 1); PG8_STAGE(PG8_SA(1, 0), a3, voffA);
            PG8_BAR; PG8_WAIT_L(0); PG8_MMA(1, 0, At, B0); PG8_BAR; PG8_SCHED;
            PG8_STAGE(PG8_SB(1, 1), b3 + hstep, voffB);
            PG8_WAIT_V(6); PG8_BAR; PG8_MMA(1, 1, At, B1); PG8_BAR;
            }
        }
        if constexpr (ALIGN_EPI) { if (wr == 0) PG8_BAR; }
        if constexpr (!Epi::AFTER_DRAIN) { E(acc, cur, wr, wc, fr, fq); S.done(cur); }
        if (!has_next) break;
#pragma unroll
        for (int a = 0; a < 2; ++a)
#pragma unroll
            for (int b = 0; b < 2; ++b)
#pragma unroll
                for (int m = 0; m < 4; ++m)
#pragma unroll
                    for (int n = 0; n < 2; ++n) acc[a][b][m][n] = (f32x4){0.f, 0.f, 0.f, 0.f};
        cur = nxt; cA = nA; cB = nB; ++ui;
        if constexpr (ALIGN_EPI) { if (wr == 1) PG8_BAR; }
    }
    PG8_WAIT_V(0);
    if constexpr (!ALIGN_EPI) { if (wr == 0) PG8_BAR; }
    PG8_BAR;
    if constexpr (Epi::AFTER_DRAIN) { E.fused(acc, cur, wr, wc, fr, fq, lds, wid, lane); S.done(cur); }
#undef PG8_SA
#undef PG8_SB
#undef PG8_STAGE
#undef PG8_LDA
#undef PG8_LDB
#undef PG8_MMA
#undef PG8_WAIT_V
#undef PG8_WAIT_L
#undef PG8_BAR
#undef PG8_SCHED
}
}


using pg8::bf16_t; using pg8::f32x4; using pg8::u32x4; using pg8::u32x2; using pg8::f32x2;
constexpr int NWAVES = 8;
constexpr int SEQ = 8192, DM = 2048, AW = 1024, BW = 1024, INW = 3072, DFF = 5632, NG = 64, NCHUNK = 512, ASK = 384;
constexpr float EPS = 1e-6f;
constexpr size_t MiB = 1u << 20;
constexpr size_t WS_CTL = 0, CTL_ZERO_BYTES = 1 * MiB;
constexpr size_t WS_LNST = 1 * MiB;
constexpr size_t WS_X1ST = 2 * MiB;
constexpr size_t WS_X2ST = 2 * MiB + 256 * 1024;
constexpr size_t WS_YAST = 2 * MiB + 512 * 1024;
constexpr size_t WS_A16 = 2 * MiB + 768 * 1024;
constexpr size_t WS_WM = 3 * MiB;
constexpr size_t WS_WIN = 4 * MiB, WS_WOUT = 16 * MiB, WS_WGU = 24 * MiB, WS_WD = 68 * MiB;
constexpr size_t WS_MQ = 90 * MiB, WS_PT = 102 * MiB, WS_SPREV = 106 * MiB;
constexpr size_t WS_XN = 114 * MiB;
constexpr size_t WS_U = 146 * MiB, WS_V = 162 * MiB, WS_AS = 178 * MiB;
constexpr size_t WS_MIX = 202 * MiB;
constexpr size_t WS_H = 146 * MiB;
constexpr size_t WS_E = 234 * MiB;
constexpr size_t WS_YBST = 250 * MiB;
constexpr size_t WS_END = 252 * MiB;
static_assert(WS_H + (size_t)SEQ * DFF * 2 <= WS_END && WS_MIX + (size_t)SEQ * DM * 2 <= WS_END && WS_END <= 256 * MiB, "d_ws map");

constexpr int LDS_BYTES = 147456;
constexpr int MISC_OFF = 131072 + 4096;

#define GAS __attribute__((address_space(1)))
#define LAS __attribute__((address_space(3)))
#define LDS_WAIT() asm volatile("s_waitcnt lgkmcnt(0)" ::: "memory")
__device__ __forceinline__ unsigned f2bf(float f) { unsigned u = __builtin_bit_cast(unsigned, f); return (u + 0x7fffu + ((u >> 16) & 1u)) >> 16; }
__device__ __forceinline__ unsigned pk2(float lo, float hi) { return f2bf(lo) | (f2bf(hi) << 16); }
__device__ __forceinline__ float bf2f(bf16_t b) { return __builtin_bit_cast(float, (unsigned)b << 16); }
__device__ __forceinline__ float wave_sum(float v) {
#pragma unroll
    for (int o = 1; o < 64; o <<= 1) v += __shfl_xor(v, o);
    return v;
}

#define XB_TMO      128
#define XB_XCNT(j)  (256  + 64 * (j))
#define XB_XSUB(j)  (1280 + 64 * (j))
#define XB_XGEN(j)  (2304 + 64 * (j))
#define XB_TOP      3328
#define XB_TOPGEN   3392
#define XCD_BAR_WORDS 3456
#define XB_SPIN_CAP (1u << 18)

__device__ __forceinline__ unsigned xb_ld(unsigned* p)              { return __hip_atomic_load(p, __ATOMIC_RELAXED, __HIP_MEMORY_SCOPE_AGENT); }
__device__ __forceinline__ unsigned xb_add(unsigned* p, unsigned v) { return __hip_atomic_fetch_add(p, v, __ATOMIC_RELAXED, __HIP_MEMORY_SCOPE_AGENT); }
__device__ __forceinline__ unsigned xb_xcc_id() { return (unsigned)__builtin_amdgcn_s_getreg((3 << 11) | 20) & 0xFu; }
#define XB_SPIN(cond, bar) do { unsigned _sp = 0; while (cond) { __builtin_amdgcn_s_sleep(1); \
    if ((++_sp & 255u) == 0u) { if (xb_ld(&(bar)[XB_TMO])) break; if (_sp > XB_SPIN_CAP) { atomicAdd(&(bar)[XB_TMO], 1u); break; } } } } while (0)

struct XcdBarrier {
    unsigned* bar; unsigned x;
    volatile LAS unsigned* st;
};

__device__ __forceinline__ XcdBarrier xcd_barrier_post(unsigned* bar, volatile LAS unsigned* st) {
    XcdBarrier b; b.bar = bar; b.x = xb_xcc_id(); b.st = st;
    if (threadIdx.x == 0) (void)xb_add(&bar[XB_XCNT(b.x)], 1u);
    return b;
}
__device__ __forceinline__ void xcd_barrier_complete(unsigned* bar, unsigned x, unsigned& nloc, unsigned& nx) {
    const unsigned G = gridDim.x * gridDim.y * gridDim.z;
    unsigned sum, cnt, mine, sp = 0u;
    for (;;) {
        sum = 0u; cnt = 0u; mine = 0u;
#pragma unroll
        for (unsigned j = 0; j < 16; ++j) { const unsigned c = xb_ld(&bar[XB_XCNT(j)]); sum += c; cnt += (c > 0u) ? 1u : 0u; mine = (j == x) ? c : mine; }
        if (sum == G) break;
        __builtin_amdgcn_s_sleep(1);
        if ((++sp & 255u) == 0u) { if (xb_ld(&bar[XB_TMO])) break; if (sp > XB_SPIN_CAP) { atomicAdd(&bar[XB_TMO], 1u); break; } }
    }
    nloc = mine > 0u ? mine : 1u; nx = cnt > 0u ? cnt : 1u;
}

__device__ __forceinline__ void xcd_barrier(const XcdBarrier& b) {
    asm volatile("s_waitcnt vmcnt(0)" ::: "memory");
    __syncthreads();
    if (threadIdx.x == 0) {
        unsigned* bar = b.bar;
        __builtin_amdgcn_s_waitcnt(0);
        unsigned nloc = b.st[0], nx = b.st[1];
        if (nloc == 0u) { xcd_barrier_complete(bar, b.x, nloc, nx); b.st[0] = nloc; b.st[1] = nx; }
        const unsigned old = xb_add(&bar[XB_XSUB(b.x)], 1u);
        const unsigned gen = old / nloc;
        if (old + 1u == (gen + 1u) * nloc) {
            __builtin_amdgcn_fence(__ATOMIC_RELEASE, "agent");
            asm volatile("s_waitcnt vmcnt(0)" ::: "memory");
            const unsigned og = xb_add(&bar[XB_TOP], 1u);
            const unsigned tg = og / nx;
            if (og + 1u == (tg + 1u) * nx) xb_add(&bar[XB_TOPGEN], 1u);
            else XB_SPIN(xb_ld(&bar[XB_TOPGEN]) == tg, bar);
            __builtin_amdgcn_fence(__ATOMIC_ACQUIRE, "agent");
            xb_add(&bar[XB_XGEN(b.x)], 1u);
            asm volatile("s_waitcnt vmcnt(0)" ::: "memory");
        } else {
            XB_SPIN(xb_ld(&bar[XB_XGEN(b.x)]) == gen, bar);
            __builtin_amdgcn_fence(__ATOMIC_ACQUIRE, "agent");
            asm volatile("s_waitcnt vmcnt(0)" ::: "memory");
        }
    }
    __syncthreads();
}

constexpr int CW_BAR = 4096;

struct Args { const float* in[24]; float* out; unsigned char* ws; int ph_lo, ph_hi, sub, pad; };

__device__ __forceinline__ void p0_transpose_item(const float* W, int K, int N, bf16_t* WT, int mode, const float* sc0, const float* sc1, int ksplit, LAS float* scr, int item, int lane) {
    const int nblk = N / 32, kb = item / nblk, nb = item % nblk, k0 = 64 * kb, n0 = 32 * nb;
#pragma unroll 8
    for (int i = 0; i < 32; ++i) { const int kk = 2 * i + (lane >> 5); scr[kk * 33 + (lane & 31)] = W[(size_t)(k0 + kk) * N + n0 + (lane & 31)]; }
    const int c = lane & 7;
    f32x4 sa = (f32x4){1.f, 1.f, 1.f, 1.f}, sb = sa;
    if (sc0) { const float* sp = (k0 < ksplit) ? (sc0 + k0) : (sc1 + (k0 - ksplit)); sa = *(const f32x4*)(sp + 8 * c); sb = *(const f32x4*)(sp + 8 * c + 4); }
    LDS_WAIT(); asm volatile("" ::: "memory");
#pragma unroll
    for (int j = 0; j < 4; ++j) { const int n = (lane >> 3) + 8 * j; const LAS float* s = scr + (8 * c) * 33 + n;
        u32x4 o; o.x = pk2(s[0 * 33] * sa[0], s[1 * 33] * sa[1]); o.y = pk2(s[2 * 33] * sa[2], s[3 * 33] * sa[3]); o.z = pk2(s[4 * 33] * sb[0], s[5 * 33] * sb[1]); o.w = pk2(s[6 * 33] * sb[2], s[7 * 33] * sb[3]);
        const int ng = n0 + n; const int row = (mode == 0) ? ng : (256 * (ng >> 7) + 128 * (mode - 1) + (ng & 127));
        *(u32x4*)(WT + (size_t)row * K + k0 + 8 * c) = o; }
    LDS_WAIT(); asm volatile("" ::: "memory");
}


__device__ __forceinline__ void cpowk(float lr, float li, float dt, int k, float& re, float& im) {
    const float mag = expf(lr * dt * (float)k), ang = li * dt * (float)k; re = mag * cosf(ang); im = mag * sinf(ang);
}
__device__ __forceinline__ void s5_co(float lr, float li, float dt, float& cor, float& coi) {
    float ar, ai; cpowk(lr, li, dt, 1, ar, ai);
    const float den = lr * lr + li * li, nr = ar - 1.0f, ni = ai; cor = (nr * lr + ni * li) / den; coi = (ni * lr - nr * li) / den;
}
struct S5P { const float *lam_re, *lam_im, *log_dt, *b_re, *b_im, *c_re, *c_im; };
__device__ __forceinline__ void p0_s5_kitem(const S5P& P, bf16_t* MQ, int g, int k, int lane) {
    const float dt = expf(P.log_dt[g]);
    float wr, wi; { const float lr = P.lam_re[g * 64 + lane], li = P.lam_im[g * 64 + lane]; float ar, ai, cor, coi; cpowk(lr, li, dt, k, ar, ai); s5_co(lr, li, dt, cor, coi); wr = ar * cor - ai * coi; wi = ar * coi + ai * cor; }
    const int kout = lane >> 2, h4 = (lane & 3) * 4;
    f32x4 acc = (f32x4){0.f, 0.f, 0.f, 0.f};
    for (int p = 0; p < 64; ++p) {
        const float pr = __shfl(wr, p), pi = __shfl(wi, p);
        const f32x4 br = *(const f32x4*)(P.b_re + (size_t)(g * 64 + p) * 16 + h4), bi = *(const f32x4*)(P.b_im + (size_t)(g * 64 + p) * 16 + h4);
        const float cr = P.c_re[(size_t)(g * 16 + kout) * 64 + p], ci = P.c_im[(size_t)(g * 16 + kout) * 64 + p];
        const f32x4 Wr = br * pr - bi * pi, Wi = bi * pr + br * pi;
        acc += Wr * cr - Wi * ci;
    }
    u32x2 w; w.x = pk2(acc[0], acc[1]); w.y = pk2(acc[2], acc[3]);
    bf16_t* base = MQ + (size_t)g * 256 * ASK;
    for (int tau = 0; tau + k < 16; ++tau) { const int t = tau + k;
        *(u32x2*)(base + (size_t)(t * 16 + kout) * ASK + tau * 16 + h4) = w;
        if (k > 0) *(u32x2*)(base + (size_t)(tau * 16 + kout) * ASK + t * 16 + h4) = (u32x2){0u, 0u}; }
}
__device__ __forceinline__ void p0_s5_qitem(const S5P& P, bf16_t* MQ, int g, int t, int lane) {
    const float dt = expf(P.log_dt[g]); const float lr = P.lam_re[g * 64 + lane], li = P.lam_im[g * 64 + lane];
    float ar, ai; cpowk(lr, li, dt, t + 1, ar, ai);
    bf16_t* base = MQ + ((size_t)g * 256 + t * 16) * ASK + 256 + lane;
#pragma unroll 4
    for (int kout = 0; kout < 16; ++kout) { const float cr = P.c_re[(size_t)(g * 16 + kout) * 64 + lane], ci = P.c_im[(size_t)(g * 16 + kout) * 64 + lane];
        base[(size_t)kout * ASK] = (bf16_t)f2bf(cr * ar - ci * ai); base[(size_t)kout * ASK + 64] = (bf16_t)f2bf(-(cr * ai + ci * ar)); }
}
__device__ __forceinline__ void p0_s5_pitem(const S5P& P, bf16_t* PT, float* A16, int g, int tau, int lane) {
    const float dt = expf(P.log_dt[g]); const float lr = P.lam_re[g * 64 + lane], li = P.lam_im[g * 64 + lane];
    float ar, ai, cor, coi; cpowk(lr, li, dt, 15 - tau, ar, ai); s5_co(lr, li, dt, cor, coi);
    const float wr = ar * cor - ai * coi, wi = ar * coi + ai * cor;
    const float* brp = P.b_re + (size_t)(g * 64 + lane) * 16; const float* bip = P.b_im + (size_t)(g * 64 + lane) * 16;
    unsigned re[8], im[8];
#pragma unroll
    for (int h = 0; h < 16; h += 2) { const float b0r = brp[h], b0i = bip[h], b1r = brp[h + 1], b1i = bip[h + 1];
        re[h >> 1] = pk2(wr * b0r - wi * b0i, wr * b1r - wi * b1i); im[h >> 1] = pk2(wr * b0i + wi * b0r, wr * b1i + wi * b1r); }
    bf16_t* r0 = PT + ((size_t)g * 128 + lane) * 256 + tau * 16; bf16_t* r1 = r0 + (size_t)64 * 256;
    *(u32x4*)(r0) = (u32x4){re[0], re[1], re[2], re[3]}; *(u32x4*)(r0 + 8) = (u32x4){re[4], re[5], re[6], re[7]};
    *(u32x4*)(r1) = (u32x4){im[0], im[1], im[2], im[3]}; *(u32x4*)(r1 + 8) = (u32x4){im[4], im[5], im[6], im[7]};
    if (tau == 0) { float a16r, a16i; cpowk(lr, li, dt, 16, a16r, a16i); A16[(g * 64 + lane) * 2] = a16r; A16[(g * 64 + lane) * 2 + 1] = a16i; }
}

__global__ void __launch_bounds__(NWAVES * 64, 2) mk_fwd(Args args) {
    extern __shared__ __attribute__((aligned(16))) unsigned char lds_raw[];
    LAS unsigned char* lds = (LAS unsigned char*)lds_raw;
    const int tid = threadIdx.x, lane = tid & 63, wave = __builtin_amdgcn_readfirstlane(tid >> 6);
    const int G = gridDim.x; const int bx = blockIdx.x; const int vcu = (G % 8 == 0) ? (bx % 8) * (G / 8) + bx / 8 : bx;
    unsigned char* ws = args.ws;
    const float* x = args.in[0]; float* out = args.out;
    bf16_t* Win_t = (bf16_t*)(ws + WS_WIN); bf16_t* Wout_t = (bf16_t*)(ws + WS_WOUT); bf16_t* Wgu_t = (bf16_t*)(ws + WS_WGU); bf16_t* Wd_t = (bf16_t*)(ws + WS_WD);
    bf16_t* XN = (bf16_t*)(ws + WS_XN); bf16_t* Ub = (bf16_t*)(ws + WS_U); bf16_t* Vb = (bf16_t*)(ws + WS_V); bf16_t* AS = (bf16_t*)(ws + WS_AS);
    bf16_t* MIX = (bf16_t*)(ws + WS_MIX); bf16_t* Hb = (bf16_t*)(ws + WS_H);
    float* LNST = (float*)(ws + WS_LNST); float* X1ST = (float*)(ws + WS_X1ST); float* X2ST = (float*)(ws + WS_X2ST); float* YAST = (float*)(ws + WS_YAST); float* YBST = (float*)(ws + WS_YBST);
    float* A16 = (float*)(ws + WS_A16); bf16_t* WM = (bf16_t*)(ws + WS_WM); bf16_t* MQ = (bf16_t*)(ws + WS_MQ); bf16_t* PT = (bf16_t*)(ws + WS_PT); float* Eb = (float*)(ws + WS_E);
    const int lo = args.ph_lo, hi = args.ph_hi;
    volatile LAS unsigned* MISC = (volatile LAS unsigned*)(lds + MISC_OFF);
    if (tid < 32) MISC[tid] = 0u;
    __syncthreads();
    XcdBarrier bar; bar.bar = (unsigned*)(ws + WS_CTL) + CW_BAR; bar.x = 0; bar.st = nullptr;
    if (hi - lo > 1) bar = xcd_barrier_post((unsigned*)(ws + WS_CTL) + CW_BAR, MISC + 8);
#define SEAM(k) do { if (IN(k) && IN((k) + 1)) xcd_barrier(bar); } while (0)
#ifndef PH_MASK
#define PH_MASK 0x1ff
#endif
#define IN(k) (((PH_MASK >> (k)) & 1) && lo <= (k) && (k) < hi)

    if (IN(0)) {
        LAS float* scr = (LAS float*)(lds + wave * 16384);
        const int gw = vcu * NWAVES + wave, NGW = G * NWAVES;
        constexpr int I_IN = (DM / 64) * (INW / 32), I_OUT = (DM / 64) * (DM / 32), I_G = (DM / 64) * (DFF / 32), I_D = (DFF / 64) * (DM / 32);
        constexpr int NITEMS = I_IN + I_OUT + 2 * I_G + I_D;
        for (int it = gw; it < NITEMS; it += NGW) {
            int r = it;
            if (r < I_IN) { p0_transpose_item(args.in[2], DM, INW, Win_t, 0, args.in[1], args.in[1], DM, scr, r, lane); continue; } r -= I_IN;
            if (r < I_OUT) { p0_transpose_item(args.in[18], DM, DM, Wout_t, 0, args.in[16], args.in[17], AW, scr, r, lane); continue; } r -= I_OUT;
            if (r < I_G) { p0_transpose_item(args.in[20], DM, DFF, Wgu_t, 1, args.in[19], args.in[19], DM, scr, r, lane); continue; } r -= I_G;
            if (r < I_G) { p0_transpose_item(args.in[21], DM, DFF, Wgu_t, 2, args.in[19], args.in[19], DM, scr, r, lane); continue; } r -= I_G;
            p0_transpose_item(args.in[22], DFF, DM, Wd_t, 0, nullptr, nullptr, 0, scr, r, lane);
        }
        for (int m = gw; m < SEQ; m += NGW) {
            const f32x4* xr = (const f32x4*)(x + (size_t)m * DM) + lane;
            f32x4 v[8]; float s = 0.f;
#pragma unroll
            for (int j = 0; j < 8; ++j) { v[j] = xr[64 * j]; s += (v[j].x * v[j].x + v[j].y * v[j].y) + (v[j].z * v[j].z + v[j].w * v[j].w); }
            const float r = 1.0f / sqrtf(wave_sum(s) * (1.0f / DM) + EPS);
            unsigned long long* o8 = (unsigned long long*)(XN + (size_t)m * DM) + lane;
#pragma unroll
            for (int j = 0; j < 8; ++j) o8[64 * j] = (unsigned long long)pk2(v[j].x * r, v[j].y * r) | ((unsigned long long)pk2(v[j].z * r, v[j].w * r) << 32);
        }

        {
            const S5P SP{args.in[7], args.in[8], args.in[9], args.in[10], args.in[11], args.in[12], args.in[13]};
            for (int it = gw; it < 3 * 1024 + 64; it += NGW) {
                if (it < 1024) p0_s5_kitem(SP, MQ, it >> 4, it & 15, lane);
                else if (it < 2048) p0_s5_qitem(SP, MQ, (it - 1024) >> 4, it & 15, lane);
                else if (it < 3072) p0_s5_pitem(SP, PT, A16, (it - 2048) >> 4, it & 15, lane);
                else { const int b = it - 3072; const float* wsrc = args.in[5] + (size_t)b * 2048;
                    for (int e = lane; e < 2048; e += 64) { const int i = ((b & 7) * 16) + (e >> 7), j = e & 127; WM[(size_t)b * 2048 + e] = (bf16_t)(((j >> 6) <= (i >> 6)) ? f2bf(wsrc[e]) : 0u); } }
            }
        }
    }

    SEAM(0);

    if (IN(1)) {
        pg8::Gemm g{XN, Win_t, SEQ, INW, DM}; pg8::StaticOrder S; S.init(SEQ, INW, G, bx);
        pg8::EpiIn E{Ub, Vb, AS, LNST};
        pg8::gemm_phase<pg8::EpiIn, pg8::StaticOrder, true, true>(lds, g, S, E);
    }


    SEAM(1);

    if (IN(2)) {
        typedef short bf16x8 __attribute__((ext_vector_type(8)));
        const float* lng = args.in[3]; const float* lnb = args.in[4]; const float* bsp = args.in[6];
        LAS bf16_t* vT = (LAS bf16_t*)lds;
        const int fr = lane & 15, fq = lane >> 4;
        const bool split = (G > 128);
        const int sp0 = split ? (bx >= 128 ? bx - 128 : 512) : bx, spstep = split ? (G - 128) : G;
        for (int item = (args.sub == 2 ? 512 : sp0); item < 512; item += spstep) {
            const int n = item >> 3, h = item & 7;
            {
                const int p = tid >> 2, cq = tid & 3; const int row = n * 128 + p;
                float s = 0.f, ss = 0.f;
#pragma unroll
                for (int i = 0; i < 8; ++i) { const f32x4 t4 = *(const f32x4*)(LNST + (size_t)row * 32 + i * 4); s += t4[0] + t4[2]; ss += t4[1] + t4[3]; }
                const float mean = s * (1.0f / AW); const float rstd = 1.0f / sqrtf(ss * (1.0f / AW) - mean * mean + EPS);
#pragma unroll
                for (int c8 = 0; c8 < 4; ++c8) { const int cl = cq * 32 + c8 * 8; const int ch = h * 128 + cl;
                    const u32x4 vw = *(const u32x4*)(Vb + (size_t)row * AW + ch);
                    const f32x4 g0 = *(const f32x4*)(lng + ch), g1 = *(const f32x4*)(lng + ch + 4), b0 = *(const f32x4*)(lnb + ch), b1 = *(const f32x4*)(lnb + ch + 4);
                    float vv[8]; vv[0] = __builtin_bit_cast(float, vw.x << 16); vv[1] = __builtin_bit_cast(float, vw.x & 0xffff0000u); vv[2] = __builtin_bit_cast(float, vw.y << 16); vv[3] = __builtin_bit_cast(float, vw.y & 0xffff0000u);
                    vv[4] = __builtin_bit_cast(float, vw.z << 16); vv[5] = __builtin_bit_cast(float, vw.z & 0xffff0000u); vv[6] = __builtin_bit_cast(float, vw.w << 16); vv[7] = __builtin_bit_cast(float, vw.w & 0xffff0000u);
#pragma unroll
                    for (int e = 0; e < 8; ++e) { const float gg = e < 4 ? g0[e] : g1[e - 4], bb = e < 4 ? b0[e] : b1[e - 4];
                        vT[(cl + e) * 136 + p] = (bf16_t)f2bf((vv[e] - mean) * rstd * gg + bb); } }
            }
            __syncthreads();
            {
                f32x4 acc[8];
#pragma unroll
                for (int nt = 0; nt < 8; ++nt) acc[nt] = (f32x4){0.f, 0.f, 0.f, 0.f};
                const int nk = (wave < 4) ? 2 : 4;
                const bf16_t* wrow = WM + ((size_t)h * 128 + wave * 16 + fr) * 128 + 8 * fq;
                for (int kk = 0; kk < nk; ++kk) {
                    const bf16x8 bfr = *(const bf16x8*)(wrow + 32 * kk);
#pragma unroll
                    for (int nt = 0; nt < 8; ++nt) { const bf16x8 afr = *(const LAS bf16x8*)(vT + (16 * nt + fr) * 136 + 32 * kk + 8 * fq);
                        acc[nt] = __builtin_amdgcn_mfma_f32_16x16x32_bf16(afr, bfr, acc[nt], 0, 0, 0); }
                }
                const int pos = n * 128 + wave * 16 + fr; const float bsv = bsp[h * 128 + wave * 16 + fr]; float q = 0.f;
#pragma unroll
                for (int nt = 0; nt < 8; ++nt) { const int c0 = h * 128 + 16 * nt + 4 * fq;
                    const u32x2 uw = *(const u32x2*)(Ub + (size_t)pos * AW + c0);
                    const float y0 = __builtin_bit_cast(float, uw.x << 16) * (acc[nt][0] + bsv), y1 = __builtin_bit_cast(float, uw.x & 0xffff0000u) * (acc[nt][1] + bsv);
                    const float y2 = __builtin_bit_cast(float, uw.y << 16) * (acc[nt][2] + bsv), y3 = __builtin_bit_cast(float, uw.y & 0xffff0000u) * (acc[nt][3] + bsv);
                    u32x2 w; w.x = pg8::cvt_pk_bf16(y0, y1); w.y = pg8::cvt_pk_bf16(y2, y3);
                    *(u32x2*)(MIX + (size_t)pos * DM + c0) = w; q += (y0 * y0 + y1 * y1) + (y2 * y2 + y3 * y3); }
                q += __shfl_xor(q, 16); q += __shfl_xor(q, 32);
                if (fq == 0) YAST[(size_t)pos * 8 + h] = q;
            }
            __syncthreads();
        }
        for (int L = (args.sub == 1 ? 128 : bx); L < 128; L += G) {
            const int g = L >> 1, half = L & 1;
            float* Ep = (float*)(ws + WS_XN) + (size_t)L * (NCHUNK * 128);
            {
                const int row = tid >> 2, qtr = tid & 3;
                const u32x4* src = (const u32x4*)(PT + (size_t)(g * 128 + row) * 256 + qtr * 64);
                u32x4 t8[8];
#pragma unroll
                for (int i = 0; i < 8; ++i) t8[i] = src[i];
                LAS u32x4* dst = (LAS u32x4*)(lds + row * 528 + qtr * 128);
#pragma unroll
                for (int i = 0; i < 8; ++i) dst[i] = t8[i];
            }
            __syncthreads();
            for (int sl = wave; sl < 16; sl += NWAVES) {
                const int c0 = sl * 32;
                f32x4 acc[2][8];
#pragma unroll
                for (int mt = 0; mt < 2; ++mt)
#pragma unroll
                    for (int nt = 0; nt < 8; ++nt) acc[mt][nt] = (f32x4){0.f, 0.f, 0.f, 0.f};
                const bf16_t* ap = AS + (size_t)(g * NCHUNK + c0 + fr) * ASK + 8 * fq;
                bf16x8 af[2][8];
#pragma unroll
                for (int ks = 0; ks < 8; ++ks) { af[0][ks] = *(const bf16x8*)(ap + 32 * ks); af[1][ks] = *(const bf16x8*)(ap + (size_t)16 * ASK + 32 * ks); }
                const LAS unsigned char* bl = lds + fr * 528 + fq * 16;
#pragma unroll
                for (int ks = 0; ks < 8; ++ks) {
#pragma unroll
                    for (int nt = 0; nt < 8; ++nt) { const bf16x8 bb = *(const LAS bf16x8*)(bl + nt * (16 * 528) + ks * 64);
                        acc[0][nt] = __builtin_amdgcn_mfma_f32_16x16x32_bf16(af[0][ks], bb, acc[0][nt], 0, 0, 0); acc[1][nt] = __builtin_amdgcn_mfma_f32_16x16x32_bf16(af[1][ks], bb, acc[1][nt], 0, 0, 0); }
                    __builtin_amdgcn_sched_barrier(0);
                }
#pragma unroll
                for (int mt = 0; mt < 2; ++mt)
#pragma unroll
                    for (int nt = 0; nt < 8; ++nt)
#pragma unroll
                        for (int r = 0; r < 4; ++r) Ep[(size_t)(c0 + 16 * mt + 4 * fq + r) * 128 + 16 * nt + fr] = acc[mt][nt][r];
            }
            asm volatile("s_waitcnt vmcnt(0)" ::: "memory"); __syncthreads();
            {
                const float a16r = A16[(g * 64 + lane) * 2], a16i = A16[(g * 64 + lane) * 2 + 1];
                float er[64], ei[64];
                const float* eb = Ep + (size_t)(wave * 64) * 128 + lane;
#pragma unroll
                for (int i = 0; i < 64; ++i) { er[i] = __hip_atomic_load(eb + (size_t)i * 128, __ATOMIC_RELAXED, __HIP_MEMORY_SCOPE_AGENT); ei[i] = __hip_atomic_load(eb + (size_t)i * 128 + 64, __ATOMIC_RELAXED, __HIP_MEMORY_SCOPE_AGENT); }
                float sr = 0.f, si = 0.f;
#pragma unroll
                for (int i = 0; i < 64; ++i) { const float nr = a16r * sr - a16i * si + er[i], ni = a16r * si + a16i * sr + ei[i]; sr = nr; si = ni; }
                LAS float* XCH = (LAS float*)(lds + 131072 + 8192);
                XCH[(wave * 64 + lane) * 2] = sr; XCH[(wave * 64 + lane) * 2 + 1] = si;
                float pr = a16r, pi = a16i;
#pragma unroll
                for (int q = 0; q < 6; ++q) { const float nr = pr * pr - pi * pi, ni = 2.0f * pr * pi; pr = nr; pi = ni; }
                __syncthreads();
                float cr = 0.f, ci = 0.f;
                for (int w2 = 0; w2 < wave; ++w2) { const float xr = XCH[(w2 * 64 + lane) * 2], xi = XCH[(w2 * 64 + lane) * 2 + 1]; const float nr = pr * cr - pi * ci + xr, ni = pr * ci + pi * cr + xi; cr = nr; ci = ni; }
                if ((wave >> 2) == half) {
                    bf16_t* sp = AS + (size_t)(g * NCHUNK + wave * 64) * ASK + 256 + lane;
#pragma unroll
                    for (int i = 0; i < 64; ++i) { sp[(size_t)i * ASK] = (bf16_t)f2bf(cr); sp[(size_t)i * ASK + 64] = (bf16_t)f2bf(ci);
                        const float nr = a16r * cr - a16i * ci + er[i], ni = a16r * ci + a16i * cr + ei[i]; cr = nr; ci = ni; }
                }
            }
            asm volatile("s_waitcnt vmcnt(0)" ::: "memory"); __syncthreads();
            {
                pg8::Gemm gm{AS, MQ, NG * NCHUNK, 256, ASK}; pg8::S5Order S{1 << 30, L};
                pg8::EpiS5 E{AS, args.in[14], args.in[15], MIX, YBST};
                pg8::gemm_phase<pg8::EpiS5, pg8::S5Order, false, true>(lds, gm, S, E);
            }
            __syncthreads();
        }
    }
    do { if (IN(2) && IN(5)) xcd_barrier(bar); } while (0);

    if (IN(5)) {
        pg8::StaticOrder S; S.init(SEQ, DM, G, bx); pg8::Unit u0;
        if (S.next(0, u0) && tid < 256) {
            const int row = u0.pm * 256 + tid; float sa = 0.f, sb = 0.f;
            { const f32x4 a0 = *(const f32x4*)(YAST + (size_t)row * 8), a1 = *(const f32x4*)(YAST + (size_t)row * 8 + 4); sa = ((a0[0] + a0[1]) + (a0[2] + a0[3])) + ((a1[0] + a1[1]) + (a1[2] + a1[3])); }
#pragma unroll 4
            for (int i = 0; i < 16; ++i) { const f32x4 b4 = *(const f32x4*)(YBST + (size_t)row * 64 + i * 4); sb += (b4[0] + b4[1]) + (b4[2] + b4[3]); }
            const float ra = 1.0f / sqrtf(sa * (1.0f / AW) + EPS), rb = 1.0f / sqrtf(sb * (1.0f / BW) + EPS);
            ((LAS float*)(lds + pg8::XT_RHO))[tid] = ra / rb; ((LAS float*)(lds + pg8::XT_RB))[tid] = rb;
        }
        __syncthreads();
        pg8::Gemm g{MIX, Wout_t, SEQ, DM, DM};
        pg8::EpiOut E{x, out, XN  , X1ST};
        pg8::gemm_phase<pg8::EpiOut, pg8::StaticOrder, false, true>(lds, g, S, E);
    }

    SEAM(5);

    if (IN(6)) {
        pg8::Gemm g{XN, Wgu_t, SEQ, 2 * DFF, DM}; pg8::StaticOrder S; S.init(SEQ, 2 * DFF, G, bx);
        pg8::EpiGU E{Hb, X1ST};
        pg8::gemm_phase<pg8::EpiGU, pg8::StaticOrder, true, true>(lds, g, S, E);
    }

    SEAM(6);

    if (IN(7)) {
        pg8::Gemm g{Hb, Wd_t, SEQ, DM, DFF}; pg8::StaticOrder S; S.init(SEQ, DM, G, bx);
        pg8::EpiDown E{out, X2ST};
        pg8::gemm_phase<pg8::EpiDown, pg8::StaticOrder, false, true>(lds, g, S, E);
    }

    SEAM(7);

    if (IN(8)) {
        const int gw = vcu * NWAVES + wave, NGW = G * NWAVES; const float* gf = args.in[23];
        for (int m = gw; m < SEQ; m += NGW) {
            const f32x4 s0 = *(const f32x4*)(X2ST + (size_t)m * 8), s1 = *(const f32x4*)(X2ST + (size_t)m * 8 + 4);
            const float r = 1.0f / sqrtf((((s0[0] + s0[1]) + (s0[2] + s0[3])) + ((s1[0] + s1[1]) + (s1[2] + s1[3]))) * (1.0f / DM) + EPS);
            f32x4* xr = (f32x4*)(out + (size_t)m * DM) + lane; const f32x4* gr = (const f32x4*)gf + lane;
#pragma unroll
            for (int j = 0; j < 8; ++j) { f32x4 v = xr[64 * j]; const f32x4 gg = gr[64 * j]; xr[64 * j] = v * r * gg; }
        }
    }
#undef IN
}

extern "C" void kernel_launch(void* const* d_in, const int* in_sizes, int n_in, void* d_out, int out_size, void* d_ws, size_t ws_size, hipStream_t stream) {
    static int grid = 0;
    if (grid == 0) {
        if (n_in != 24 || in_sizes[0] != SEQ * DM || out_size != SEQ * DM || ws_size < WS_END) { fprintf(stderr, "kernel_launch: unexpected shapes (n_in %d, in0 %d, out %d, ws %zu)\n", n_in, n_in > 0 ? in_sizes[0] : -1, out_size, ws_size); grid = -1; return; }
        int dev = 0, cus = 0;
        if (hipGetDevice(&dev) != hipSuccess || hipDeviceGetAttribute(&cus, hipDeviceAttributeMultiprocessorCount, dev) != hipSuccess) { grid = -1; return; }
        if (hipFuncSetAttribute((const void*)mk_fwd, hipFuncAttributeMaxDynamicSharedMemorySize, LDS_BYTES) != hipSuccess) { fprintf(stderr, "kernel_launch: hipFuncSetAttribute failed\n"); grid = -1; return; }
        (void)hipGetLastError();
        grid = cus;
    }
    if (grid < 0) return;
    Args a{};
    for (int i = 0; i < 24; ++i) a.in[i] = (const float*)d_in[i];
    a.out = (float*)d_out; a.ws = (unsigned char*)d_ws;
    auto run = [&](int lo, int hi) { a.ph_lo = lo; a.ph_hi = hi; hipLaunchKernelGGL(mk_fwd, dim3(grid), dim3(NWAVES * 64), LDS_BYTES, stream, a); };
#ifndef MK_N_LAUNCHES
#define MK_N_LAUNCHES 1
#endif
#if MK_N_LAUNCHES == 1
    if (hipMemsetAsync((char*)d_ws + WS_CTL, 0, 32768, stream) != hipSuccess) { fprintf(stderr, "kernel_launch: hipMemsetAsync failed\n"); return; }
    run(0, 9);
#ifdef PROBE_EXTRA
    { const int ex[] = {PROBE_EXTRA}; for (int p : ex) { a.sub = p >> 8; run(p & 255, (p & 255) + 1); } a.sub = 0; }
#endif
#else
    for (int p = 0; p < 9; ++p) run(p, p + 1);
#endif
}
```
